# Optimizing an MI355X kernel written in HIP

```python
import math
import jax, jax.numpy as jnp
from jax import lax
import numpy as np

D_MODEL = 1024
BATCH = 16
SEQ = 2048
DEPTH = 2

HEAD_DIM = 64
N_HEADS = D_MODEL // HEAD_DIM
N_SB_HEADS = N_HEADS // 2
N_SWA_HEADS = N_HEADS - N_SB_HEADS
N_SWA_KV = 2
N_FOX_HEADS = N_HEADS
WINDOW = 128
BLOCK = 128
N_BUCKETS = 32
MAX_DISTANCE = 128
D_FF = 2816
ALPHA = (2 * DEPTH) ** 0.25
INIT_BETA = (8 * DEPTH) ** -0.25
LN_EPS = 1e-5
N_EVEN = (DEPTH + 1) // 2
N_ODD = DEPTH // 2

SB_W = N_SB_HEADS * HEAD_DIM
SWA_QW = N_SWA_HEADS * HEAD_DIM
SWA_KVW = N_SWA_KV * HEAD_DIM
AB_IN = 3 * SB_W + SWA_QW + 2 * SWA_KVW
AB_OUT = SB_W + SWA_QW
FOX_W = N_FOX_HEADS * HEAD_DIM
FOX_IN = 3 * FOX_W + N_FOX_HEADS

kernel_name = "hybrid_stickbreak_swa_fox_deepnorm"


def layer_norm(x, g, b):
    xf = x.astype(jnp.float32)
    mu = jnp.mean(xf, axis=-1, keepdims=True)
    var = jnp.mean(jnp.square(xf - mu), axis=-1, keepdims=True)
    return ((xf - mu) * lax.rsqrt(var + LN_EPS)).astype(x.dtype) * g + b


def swiglu_ffn(x, w_in, w_out):
    gate, up = jnp.split(x @ w_in, 2, axis=-1)
    return (jax.nn.silu(gate) * up) @ w_out


def t5_causal_bucket(rel):
    n = jnp.maximum(rel, 0)
    max_exact = N_BUCKETS // 2
    nf = jnp.maximum(n, 1).astype(jnp.float32)
    large = max_exact + (jnp.log(nf / max_exact) / math.log(MAX_DISTANCE / max_exact)
                         * (N_BUCKETS - max_exact)).astype(jnp.int32)
    large = jnp.minimum(large, N_BUCKETS - 1)
    return jnp.where(n < max_exact, n, large)


def stick_breaking_attention(q, k, v):
    S, Dh = q.shape[1], q.shape[3]
    scale = Dh ** -0.5
    outs = []
    for blk in range(S // BLOCK):
        q0, end = blk * BLOCK, (blk + 1) * BLOCK
        z = jnp.einsum('bqhd,bkhd->bhqk', q[:, q0:end], k[:, :end]).astype(jnp.float32) * scale
        t_pos = q0 + jnp.arange(BLOCK)[:, None]
        s_pos = jnp.arange(end)[None, :]
        strict = s_pos < t_pos
        log_keep = jnp.where(strict, jax.nn.log_sigmoid(-z), 0.0)
        after = lax.cumsum(log_keep, axis=3, reverse=True) - log_keep
        w = jnp.where(strict, jnp.exp(jax.nn.log_sigmoid(z) + after), 0.0)
        outs.append(jnp.einsum('bhqk,bkhd->bqhd', w.astype(v.dtype), v[:, :end]))
    return jnp.concatenate(outs, axis=1)


def sliding_window_sink_attention(q, k, v, sinks, rel_bias):
    B, S, Hq, Dh = q.shape
    Hkv = k.shape[2]
    G = Hq // Hkv
    nb = S // BLOCK
    qb = q.reshape(B, nb, BLOCK, Hkv, G, Dh)

    def band(t):
        tb = t.reshape(B, nb, BLOCK, Hkv, Dh)
        prev = jnp.pad(tb, ((0, 0), (1, 0), (0, 0), (0, 0), (0, 0)))[:, :-1]
        return jnp.concatenate([prev, tb], axis=2)

    kb, vb = band(k), band(v)
    logits = jnp.einsum('bnqhgd,bnkhd->bnhgqk', qb, kb).astype(jnp.float32) * Dh ** -0.5
    qi = jnp.arange(BLOCK)[:, None]
    kj = jnp.arange(2 * BLOCK)[None, :]
    rel = qi + BLOCK - kj
    bias = rel_bias[t5_causal_bucket(rel)].astype(jnp.float32)
    bias = bias.transpose(2, 0, 1).reshape(Hkv, G, BLOCK, 2 * BLOCK)
    in_window = (rel >= 0) & (rel < WINDOW)
    key_pos = jnp.arange(nb)[:, None, None] * BLOCK - BLOCK + kj[None]
    valid = in_window[None] & (key_pos >= 0)
    logits = jnp.where(valid[None, :, None, None], logits + bias, -jnp.inf)
    sink = sinks.astype(jnp.float32).reshape(Hkv, G, 1, 1)
    m = jnp.maximum(jnp.max(logits, axis=-1, keepdims=True), sink)
    p = jnp.exp(logits - m)
    w = p / (jnp.sum(p, axis=-1, keepdims=True) + jnp.exp(sink - m))
    out = jnp.einsum('bnhgqk,bnkhd->bnqhgd', w.astype(v.dtype), vb)
    return out.reshape(B, S, Hq, Dh)


def forgetting_attention(q, k, v, log_f):
    S, Dh = q.shape[1], q.shape[3]
    scale = Dh ** -0.5
    c = lax.cumsum(log_f, axis=1).transpose(0, 2, 1)
    outs = []
    for blk in range(S // BLOCK):
        q0, end = blk * BLOCK, (blk + 1) * BLOCK
        logits = jnp.einsum('bqhd,bkhd->bhqk', q[:, q0:end], k[:, :end]).astype(jnp.float32) * scale
        logits = logits + c[:, :, q0:end, None] - c[:, :, None, :end]
        causal = jnp.arange(end)[None, :] <= (q0 + jnp.arange(BLOCK)[:, None])
        w = jax.nn.softmax(jnp.where(causal, logits, -jnp.inf), axis=-1)
        outs.append(jnp.einsum('bhqk,bkhd->bqhd', w.astype(v.dtype), v[:, :end]))
    return jnp.concatenate(outs, axis=1)


def even_mixer(h, w_in, w_out, sinks, rel_bias):
    B, S, _ = h.shape
    proj = h @ w_in
    cuts = [SB_W, 2 * SB_W, 3 * SB_W, 3 * SB_W + SWA_QW, 3 * SB_W + SWA_QW + SWA_KVW]
    sb_q, sb_k, sb_v, sw_q, sw_k, sw_v = jnp.split(proj, cuts, axis=-1)
    heads = lambda t, n: t.reshape(B, S, n, HEAD_DIM)
    o_sb = stick_breaking_attention(heads(sb_q, N_SB_HEADS), heads(sb_k, N_SB_HEADS),
                                    heads(sb_v, N_SB_HEADS))
    o_sw = sliding_window_sink_attention(heads(sw_q, N_SWA_HEADS), heads(sw_k, N_SWA_KV),
                                         heads(sw_v, N_SWA_KV), sinks, rel_bias)
    o = jnp.concatenate([o_sb.reshape(B, S, SB_W), o_sw.reshape(B, S, SWA_QW)], axis=-1)
    return o @ w_out


def odd_mixer(h, w_in, b_f, w_out):
    B, S, _ = h.shape
    proj = h @ w_in
    q, k, v, f = jnp.split(proj, [FOX_W, 2 * FOX_W, 3 * FOX_W], axis=-1)
    heads = lambda t: t.reshape(B, S, N_FOX_HEADS, HEAD_DIM)
    log_f = jax.nn.log_sigmoid((f + b_f).astype(jnp.float32))
    o = forgetting_attention(heads(q), heads(k), heads(v), log_f)
    return o.reshape(B, S, FOX_W) @ w_out


def setup_inputs(seed: int = 0) -> dict:
    key = jax.random.key(seed)
    ks = jax.random.split(key, 16)
    nrm = lambda k, shape, s: jax.random.normal(k, shape, jnp.float32) * s
    return {
        "x": nrm(ks[0], (BATCH, SEQ, D_MODEL), 1.0),
        "ln_g": 1.0 + nrm(ks[1], (DEPTH, 3, D_MODEL), 0.05),
        "ln_b": nrm(ks[2], (DEPTH, 3, D_MODEL), 0.02),
        "ffn1_in": nrm(ks[3], (DEPTH, D_MODEL, 2 * D_FF), D_MODEL ** -0.5),
        "ffn1_out": nrm(ks[4], (DEPTH, D_FF, D_MODEL), D_FF ** -0.5 * INIT_BETA),
        "ffn2_in": nrm(ks[5], (DEPTH, D_MODEL, 2 * D_FF), D_MODEL ** -0.5),
        "ffn2_out": nrm(ks[6], (DEPTH, D_FF, D_MODEL), D_FF ** -0.5 * INIT_BETA),
        "ab_w_in": nrm(ks[7], (N_EVEN, D_MODEL, AB_IN), D_MODEL ** -0.5),
        "ab_w_out": nrm(ks[8], (N_EVEN, AB_OUT, D_MODEL), AB_OUT ** -0.5 * INIT_BETA),
        "ab_sinks": nrm(ks[9], (N_EVEN, N_SWA_HEADS), 0.1),
        "fox_w_in": nrm(ks[10], (N_ODD, D_MODEL, FOX_IN), D_MODEL ** -0.5),
        "fox_b_f": nrm(ks[11], (N_ODD, N_FOX_HEADS), 0.1),
        "fox_w_out": nrm(ks[12], (N_ODD, FOX_W, D_MODEL), FOX_W ** -0.5 * INIT_BETA),
        "rel_bias": nrm(ks[13], (N_BUCKETS, N_SWA_HEADS), 0.2),
    }


def reference(x, ln_g, ln_b, ffn1_in, ffn1_out, ffn2_in, ffn2_out, ab_w_in, ab_w_out,
              ab_sinks, fox_w_in, fox_b_f, fox_w_out, rel_bias):
    h = x
    for layer in range(DEPTH):
        h = layer_norm(ALPHA * h + 0.5 * swiglu_ffn(h, ffn1_in[layer], ffn1_out[layer]),
                       ln_g[layer, 0], ln_b[layer, 0])
        if layer % 2 == 0:
            i = layer // 2
            mix = even_mixer(h, ab_w_in[i], ab_w_out[i], ab_sinks[i], rel_bias)
        else:
            i = layer // 2
            mix = odd_mixer(h, fox_w_in[i], fox_b_f[i], fox_w_out[i])
        h = layer_norm(ALPHA * h + mix, ln_g[layer, 1], ln_b[layer, 1])
        h = layer_norm(ALPHA * h + 0.5 * swiglu_ffn(h, ffn2_in[layer], ffn2_out[layer]),
                       ln_g[layer, 2], ln_b[layer, 2])
    return h
```

```cpp
#include <hip/hip_runtime.h>
#include <hip/hip_cooperative_groups.h>
#include <cstdint>
#include <cstdio>
#include <cmath>
namespace cg = cooperative_groups;

#ifndef MK_N_LAUNCHES
#define MK_N_LAUNCHES 1
#endif

#ifndef EN_P0
#define EN_P0 1
#endif
#ifndef EN_G1
#define EN_G1 1
#endif
#ifndef EN_G2
#define EN_G2 1
#endif
#ifndef EN_LN
#define EN_LN 1
#endif
#ifndef EN_G3
#define EN_G3 1
#endif
#ifndef EN_SB
#define EN_SB 1
#endif
#ifndef EN_SWA
#define EN_SWA 1
#endif
#ifndef EN_FOX
#define EN_FOX 1
#endif
#ifndef WGM_FFN_IN
#define WGM_FFN_IN 4
#endif
#ifndef WGM_OUT
#define WGM_OUT 4
#endif
#ifndef WGM_QKV
#define WGM_QKV 4
#endif
#define LAS __attribute__((address_space(3)))
typedef unsigned short bf16_t;
typedef short bf16x8 __attribute__((ext_vector_type(8)));
typedef float f32x2 __attribute__((ext_vector_type(2)));
typedef float f32x4 __attribute__((ext_vector_type(4)));
typedef float f32x16 __attribute__((ext_vector_type(16)));
typedef unsigned u32x2 __attribute__((ext_vector_type(2)));
typedef unsigned u32x4 __attribute__((ext_vector_type(4)));
typedef __bf16 bf16x2_t __attribute__((ext_vector_type(2)));

constexpr int D_MODEL = 1024, BATCH = 16, SEQ = 2048, MTOK = BATCH * SEQ, D_FF = 2816;
constexpr int AB_IN = 2304, FOX_QKV = 3072, FOX_IN = 3088, FOX_NPAD = 3328;
constexpr float LOG2E = 1.4426950408889634f;
constexpr float QSCALE = 0.125f * LOG2E;
constexpr float ALPHA = 1.4142135623730951f;
constexpr float LN_EPS = 1e-5f;

__device__ __forceinline__ unsigned cvt_pk(float lo, float hi) { f32x2 v = {lo, hi}; bf16x2_t b = __builtin_convertvector(v, bf16x2_t); return __builtin_bit_cast(unsigned, b); }
__device__ __forceinline__ float ex2(float x) { return __builtin_amdgcn_exp2f(x); }
__device__ __forceinline__ float lg2(float x) { return __builtin_amdgcn_logf(x); }

namespace pg8 {
constexpr int BM = 256, BK = 64, HALF = 128, HTB = HALF * BK * 2, STAGE_BYTES = 8 * HTB, NXCD = 8;
__host__ __device__ __forceinline__ int lds_byte(int r, int c) { const int st = (r >> 4) * 2 + (c >> 5), rr = r & 15, cc = c & 31, ob = rr * 64 + cc * 2; return st * 1024 + (ob ^ (((ob >> 9) & 1) << 5)); }
__host__ __device__ __forceinline__ void stage_rc(int b, int& R, int& C) { const int st = b / 1024, sb = b % 1024, swz = sb ^ (((sb >> 9) & 1) << 5); R = (st >> 1) * 16 + swz / 64; C = (st & 1) * 32 + (swz % 64) / 2; }
__host__ __device__ __forceinline__ int perm32(int rho) { const int n = rho >> 4, i = rho & 15; return 8 * (i >> 2) + 4 * n + (i & 3); }

struct Unit { int pm, pn; };
struct Gemm { const bf16_t* A; const bf16_t* Bt; int M, N, K; };

struct StaticOrder {
    int nM, nN, nwg, G, c, WGM;
    __host__ __device__ void init(int M, int N, int G_, int c_, int wgm_) { nM = M / BM; nN = N / BM; nwg = nM * nN; G = G_; c = c_; WGM = wgm_; }
    __host__ __device__ bool next(int i, Unit& u) const {
        const long L = (long)i * G + c; if (L >= nwg) return false;
        int wgid = (int)L; { const int q = nwg / NXCD, r = nwg % NXCD, xcd = wgid % NXCD, off = wgid / NXCD; wgid = (xcd < r ? xcd * (q + 1) : r * (q + 1) + (xcd - r) * q) + off; }
        const int nig = WGM * nN, gid = wgid / nig, fm = gid * WGM, gsz = (nM - fm) < WGM ? (nM - fm) : WGM;
        u.pm = fm + ((wgid % nig) % gsz); u.pn = (wgid % nig) / gsz; return true;
    }
};

struct EpiSwiGLU {
    static constexpr bool PERM = true;
    bf16_t* O; int ldc;
    __device__ __forceinline__ void operator()(const f32x4 (&acc)[2][2][4][2], const Unit& u, int wr, int wc, int fr, int fq) const {
        const int row0 = u.pm * BM + wr * 64 + fr; const int col0 = u.pn * HALF + wc * 32 + 8 * fq;
#pragma unroll
        for (int ai = 0; ai < 2; ++ai)
#pragma unroll
            for (int m = 0; m < 4; ++m) {
                bf16_t* rowp = O + (size_t)(row0 + ai * HALF + m * 16) * ldc + col0;
                float v[8];
#pragma unroll
                for (int n = 0; n < 2; ++n)
#pragma unroll
                    for (int j = 0; j < 4; ++j) { const float g = acc[ai][0][m][n][j], up = acc[ai][1][m][n][j];
                        v[n * 4 + j] = g * __builtin_amdgcn_rcpf(1.f + ex2(-LOG2E * g)) * up; }
                u32x4 w; w.x = cvt_pk(v[0], v[1]); w.y = cvt_pk(v[2], v[3]); w.z = cvt_pk(v[4], v[5]); w.w = cvt_pk(v[6], v[7]);
                *(u32x4*)rowp = w;
            }
    }
};
struct EpiQKV {
    static constexpr bool PERM = true;
    bf16_t* O; int ldc; unsigned qmask; float* F; int ftile;
    __device__ __forceinline__ void operator()(const f32x4 (&acc)[2][2][4][2], const Unit& u, int wr, int wc, int fr, int fq) const {
        const int row0 = u.pm * BM + wr * 64 + fr;
        if (u.pn == ftile) {
            if (wc == 0 && fq < 2) {
#pragma unroll
                for (int ai = 0; ai < 2; ++ai)
#pragma unroll
                    for (int m = 0; m < 4; ++m) { float* fp = F + (size_t)(row0 + ai * HALF + m * 16) * 16 + 8 * fq; *(f32x4*)fp = acc[ai][0][m][0]; *(f32x4*)(fp + 4) = acc[ai][0][m][1]; }
            }
            return;
        }
        const float sc = ((qmask >> u.pn) & 1u) ? QSCALE : 1.f;
        const int col0 = u.pn * BM + wc * 32 + 8 * fq;
#pragma unroll
        for (int ai = 0; ai < 2; ++ai)
#pragma unroll
            for (int m = 0; m < 4; ++m) { bf16_t* rowp = O + (size_t)(row0 + ai * HALF + m * 16) * ldc + col0;
#pragma unroll
                for (int bj = 0; bj < 2; ++bj) { const f32x4 v0 = acc[ai][bj][m][0] * sc, v1 = acc[ai][bj][m][1] * sc;
                    u32x4 w; w.x = cvt_pk(v0[0], v0[1]); w.y = cvt_pk(v0[2], v0[3]); w.z = cvt_pk(v1[0], v1[1]); w.w = cvt_pk(v1[2], v1[3]);
                    *(u32x4*)(rowp + bj * HALF) = w; } }
    }
};
struct EpiLnFused {
    static constexpr bool PERM = true;
    float* out32; bf16_t* hb; unsigned char* lob; float alpha, cs; const float* g; const float* b;
    unsigned long long* xbuf; unsigned* cnt; LAS unsigned char* xl;
    __device__ __forceinline__ void operator()(f32x4 (&acc)[2][2][4][2], const Unit& u, int wr, int wc, int fr, int fq) const {
        const int col0 = u.pn * BM + wc * 32 + 8 * fq; const int wid = wr * 4 + wc, lane = fq * 16 + fr, tid = wid * 64 + lane;
        LAS f32x2* P = (LAS f32x2*)xl; LAS f32x2* S = (LAS f32x2*)(xl + 8192); volatile LAS unsigned* flag = (volatile LAS unsigned*)(xl + 8192 + 2048);
        {
        const bf16_t* hbp = hb; const unsigned char* lobp = lob;
#pragma unroll
        for (int ai = 0; ai < 2; ++ai) {
            u32x4 hv[4][2]; u32x2 lv[4][2];
#pragma unroll
            for (int m = 0; m < 4; ++m) { const size_t off = (size_t)(u.pm * BM + ai * HALF + wr * 64 + m * 16 + fr) * D_MODEL + col0;
#pragma unroll
                for (int bj = 0; bj < 2; ++bj) { hv[m][bj] = *(const u32x4*)(hbp + off + bj * HALF); lv[m][bj] = *(const u32x2*)(lobp + off + bj * HALF); } }
#pragma unroll
            for (int m = 0; m < 4; ++m) {
#pragma unroll
                for (int bj = 0; bj < 2; ++bj)
#pragma unroll
                    for (int n = 0; n < 2; ++n) { const unsigned h0 = n ? hv[m][bj].z : hv[m][bj].x, h1 = n ? hv[m][bj].w : hv[m][bj].y; const unsigned lw = n ? lv[m][bj].y : lv[m][bj].x; f32x4 r;
                        r[0] = __builtin_bit_cast(float, h0 << 16) - 0.03125f + (float)(lw & 0xffu) * 0.000244140625f;
                        r[1] = __builtin_bit_cast(float, h0 & 0xffff0000u) - 0.03125f + (float)((lw >> 8) & 0xffu) * 0.000244140625f;
                        r[2] = __builtin_bit_cast(float, h1 << 16) - 0.03125f + (float)((lw >> 16) & 0xffu) * 0.000244140625f;
                        r[3] = __builtin_bit_cast(float, h1 & 0xffff0000u) - 0.03125f + (float)(lw >> 24) * 0.000244140625f;
                        acc[ai][bj][m][n] = r * alpha + acc[ai][bj][m][n] * cs; }
                asm volatile("" : "+v"(acc[ai][0][m][0]), "+v"(acc[ai][0][m][1]), "+v"(acc[ai][1][m][0]), "+v"(acc[ai][1][m][1])); }
            asm volatile("" : "+s"(hbp), "+s"(lobp) : "v"(acc[ai][1][3][1][3]) : "memory");
        }
        }
#pragma unroll
        for (int ai = 0; ai < 2; ++ai)
#pragma unroll
            for (int m = 0; m < 4; ++m) {
                float s1 = 0.f, s2 = 0.f;
#pragma unroll
                for (int bj = 0; bj < 2; ++bj)
#pragma unroll
                    for (int n = 0; n < 2; ++n) { const f32x4 x = acc[ai][bj][m][n]; s1 += (x[0] + x[1]) + (x[2] + x[3]); s2 += (x[0] * x[0] + x[1] * x[1]) + (x[2] * x[2] + x[3] * x[3]); }
                s1 += __shfl_xor(s1, 16); s1 += __shfl_xor(s1, 32); s2 += __shfl_xor(s2, 16); s2 += __shfl_xor(s2, 32);
                if (fq == 0) P[(ai * HALF + wr * 64 + m * 16 + fr) * 4 + wc] = (f32x2){s1, s2};
                __builtin_amdgcn_sched_barrier(0);
            }
        asm volatile("s_waitcnt lgkmcnt(0)" ::: "memory"); __builtin_amdgcn_s_barrier(); asm volatile("" ::: "memory");
        unsigned* pc = cnt + 64 * u.pm;
        if (tid < 256) { const f32x2 a = P[tid * 4 + 0], bq = P[tid * 4 + 1], c = P[tid * 4 + 2], d = P[tid * 4 + 3];
            const float t1 = (a.x + bq.x) + (c.x + d.x), t2 = (a.y + bq.y) + (c.y + d.y);
            __hip_atomic_store(xbuf + ((size_t)(u.pm * BM + tid) * 4 + u.pn), ((unsigned long long)__float_as_uint(t2) << 32) | __float_as_uint(t1), __ATOMIC_RELAXED, __HIP_MEMORY_SCOPE_AGENT); }
        asm volatile("s_waitcnt vmcnt(0)" ::: "memory");
        if (wid < 4 && lane == 0) __hip_atomic_fetch_add(pc, 1u, __ATOMIC_RELAXED, __HIP_MEMORY_SCOPE_AGENT);
        if (wid == 0) {
            for (unsigned sp = 0; sp < (1u << 20); ++sp) {
                if ((unsigned)__builtin_amdgcn_readfirstlane(__hip_atomic_load(pc, __ATOMIC_RELAXED, __HIP_MEMORY_SCOPE_AGENT)) >= 16u) break;
                __builtin_amdgcn_s_sleep(2);
            }
            __builtin_amdgcn_fence(__ATOMIC_ACQUIRE, "agent");
            if (lane == 0) flag[0] = 1u;
        }
        asm volatile("s_waitcnt vmcnt(0) lgkmcnt(0)" ::: "memory"); __builtin_amdgcn_s_barrier(); asm volatile("" ::: "memory");
        if (tid < 256) { const unsigned long long* slot = xbuf + (size_t)(u.pm * BM + tid) * 4; float t1 = 0.f, t2 = 0.f;
#pragma unroll
            for (int t = 0; t < 4; ++t) { const unsigned long long w = __hip_atomic_load(slot + t, __ATOMIC_RELAXED, __HIP_MEMORY_SCOPE_AGENT); t1 += __uint_as_float((unsigned)w); t2 += __uint_as_float((unsigned)(w >> 32)); }
            const float mean = t1 * (1.f / D_MODEL); const float var = fmaxf(t2 * (1.f / D_MODEL) - mean * mean, 0.f);
            S[tid] = (f32x2){mean, 1.f / sqrtf(var + LN_EPS)}; }
        asm volatile("s_waitcnt lgkmcnt(0)" ::: "memory"); __builtin_amdgcn_s_barrier(); asm volatile("" ::: "memory");
        f32x4 gv[2][2], bv[2][2];
#pragma unroll
        for (int bj = 0; bj < 2; ++bj)
#pragma unroll
            for (int n = 0; n < 2; ++n) { gv[bj][n] = *(const f32x4*)(g + col0 + bj * HALF + n * 4); bv[bj][n] = *(const f32x4*)(b + col0 + bj * HALF + n * 4); }
        if (out32) {
#pragma unroll
        for (int ai = 0; ai < 2; ++ai)
#pragma unroll
            for (int m = 0; m < 4; ++m) { const int rt = ai * HALF + wr * 64 + m * 16 + fr; const f32x2 st = S[rt]; const size_t off = (size_t)(u.pm * BM + rt) * D_MODEL + col0;
#pragma unroll
                for (int bj = 0; bj < 2; ++bj)
#pragma unroll
                    for (int n = 0; n < 2; ++n) *(f32x4*)(out32 + off + bj * HALF + n * 4) = (acc[ai][bj][m][n] - st.x) * st.y * gv[bj][n] + bv[bj][n];
                __builtin_amdgcn_sched_barrier(0); }
        } else {
#pragma unroll
        for (int ai = 0; ai < 2; ++ai)
#pragma unroll
            for (int m = 0; m < 4; ++m) { const int rt = ai * HALF + wr * 64 + m * 16 + fr; const f32x2 st = S[rt]; const size_t off = (size_t)(u.pm * BM + rt) * D_MODEL + col0;
#pragma unroll
                for (int bj = 0; bj < 2; ++bj) { u32x4 wv; u32x2 qv;
#pragma unroll
                    for (int n = 0; n < 2; ++n) { const f32x4 y = (acc[ai][bj][m][n] - st.x) * st.y * gv[bj][n] + bv[bj][n];
                        const unsigned w0 = cvt_pk(y[0], y[1]), w1 = cvt_pk(y[2], y[3]);
                        const float l0 = (y[0] - __builtin_bit_cast(float, w0 << 16)) * 4096.f + 128.5f, l1 = (y[1] - __builtin_bit_cast(float, w0 & 0xffff0000u)) * 4096.f + 128.5f;
                        const float l2 = (y[2] - __builtin_bit_cast(float, w1 << 16)) * 4096.f + 128.5f, l3 = (y[3] - __builtin_bit_cast(float, w1 & 0xffff0000u)) * 4096.f + 128.5f;
                        const unsigned q = (unsigned)(int)fminf(fmaxf(l0, 0.f), 255.f) | ((unsigned)(int)fminf(fmaxf(l1, 0.f), 255.f) << 8) | ((unsigned)(int)fminf(fmaxf(l2, 0.f), 255.f) << 16) | ((unsigned)(int)fminf(fmaxf(l3, 0.f), 255.f) << 24);
                        if (n == 0) { wv.x = w0; wv.y = w1; qv.x = q; } else { wv.z = w0; wv.w = w1; qv.y = q; } }
                    *(u32x4*)(hb + off + bj * HALF) = wv; *(u32x2*)(lob + off + bj * HALF) = qv; }
                __builtin_amdgcn_sched_barrier(0); }
        }
    }
};

template <class Epi, class Sched, bool ALIGN_EPI = true>
__device__ __forceinline__ void gemm_phase(LAS unsigned char* lds, const Gemm g, const Sched& S, const Epi& E) {
    int tid = threadIdx.x; asm volatile("" : "+v"(tid));
    const int wid = __builtin_amdgcn_readfirstlane(tid >> 6), lane = tid & 63, wr = wid >> 2, wc = wid & 3, fr = lane & 15, fq = lane >> 4;
    const int K = g.K, nt = K / BK;
    unsigned voffA[2], voffB[2];
#pragma unroll
    for (int i = 0; i < 2; ++i) { int R, C; stage_rc(tid * 16 + i * 8192, R, C); const int Rb = Epi::PERM ? ((R & ~31) + perm32(R & 31)) : R;
        voffA[i] = (unsigned)(R * K + C) * 2u; voffB[i] = (unsigned)(Rb * K + C) * 2u; }
    const size_t kstep = (size_t)(BK * 2);
    const size_t hstep = (size_t)HALF * K * 2;
    const size_t tstep = 2 * hstep;
    const unsigned ldsw = (unsigned)wid * 1024u;
    const int aoff = lds_byte(wr * 64 + fr, fq * 8), boff = lds_byte(wc * 32 + fr, fq * 8);
#define PG8_SA(b, h) (((b) * 2 + (h)) * HTB)
#define PG8_SB(b, h) ((4 + (b) * 2 + (h)) * HTB)
#define PG8_STAGE(bufoff, gbase, voff) do { _Pragma("unroll") for (int _i = 0; _i < 2; ++_i) \
        __builtin_amdgcn_global_load_lds((const unsigned*)((const char*)(gbase) + (voff)[_i]), (LAS unsigned*)(lds + (bufoff) + ldsw + _i * 8192), 16, 0, 0); } while (0)
#define PG8_LDA(dst, b, h) do { _Pragma("unroll") for (int m = 0; m < 4; ++m) _Pragma("unroll") for (int k = 0; k < 2; ++k) dst[m][k] = *(const LAS bf16x8*)(lds + PG8_SA(b, h) + aoff + m * 2048 + k * 1024); } while (0)
#define PG8_LDB(dst, b, h) do { _Pragma("unroll") for (int n = 0; n < 2; ++n) _Pragma("unroll") for (int k = 0; k < 2; ++k) dst[n][k] = *(const LAS bf16x8*)(lds + PG8_SB(b, h) + boff + n * 2048 + k * 1024); } while (0)
#define PG8_MMA(ai, bj, At, Bt) do { __builtin_amdgcn_s_setprio(1); _Pragma("unroll") for (int m = 0; m < 4; ++m) _Pragma("unroll") for (int n = 0; n < 2; ++n) _Pragma("unroll") for (int k = 0; k < 2; ++k) \
        acc[ai][bj][m][n] = __builtin_amdgcn_mfma_f32_16x16x32_bf16(Bt[n][k], At[m][k], acc[ai][bj][m][n], 0, 0, 0); __builtin_amdgcn_s_setprio(0); } while (0)
#define PG8_WAIT_V(n) asm volatile("s_waitcnt vmcnt(" #n ")" ::: "memory")
#define PG8_WAIT_L(n) asm volatile("s_waitcnt lgkmcnt(" #n ")" ::: "memory")
#define PG8_BAR __builtin_amdgcn_s_barrier()
#define PG8_SCHED __builtin_amdgcn_sched_barrier(0)
    Unit cur, nxt; int ui = 0;
    if (!S.next(0, cur)) return;
    f32x4 acc[2][2][4][2];
#pragma unroll
    for (int a = 0; a < 2; ++a)
#pragma unroll
        for (int b = 0; b < 2; ++b)
#pragma unroll
            for (int m = 0; m < 4; ++m)
#pragma unroll
                for (int n = 0; n < 2; ++n) acc[a][b][m][n] = (f32x4){0.f, 0.f, 0.f, 0.f};
    bf16x8 At[4][2], B0[2][2], B1[2][2];
    const char* cA = (const char*)g.A + (size_t)cur.pm * tstep; const char* cB = (const char*)g.Bt + (size_t)cur.pn * tstep;
    PG8_STAGE(PG8_SB(0, 0), cB, voffB); PG8_STAGE(PG8_SB(0, 1), cB + hstep, voffB); PG8_STAGE(PG8_SA(0, 0), cA, voffA); PG8_STAGE(PG8_SA(0, 1), cA + hstep, voffA);
    if (wr == 1) PG8_BAR;
    PG8_WAIT_V(2); PG8_BAR;
    PG8_STAGE(PG8_SB(1, 0), cB + kstep, voffB); PG8_STAGE(PG8_SA(1, 0), cA + kstep, voffA); PG8_STAGE(PG8_SB(1, 1), cB + hstep + kstep, voffB);
    PG8_WAIT_V(6); PG8_BAR;
    for (;;) {
        const bool has_next = S.next(ui + 1, nxt);
        const char* nA = has_next ? (const char*)g.A + (size_t)nxt.pm * tstep : cA; const char* nB = has_next ? (const char*)g.Bt + (size_t)nxt.pn * tstep : cB;
        for (int t = 0; t < nt; t += 2) {
            const bool last = (t == nt - 2);
            const char* a1 = cA + (size_t)(t + 1) * kstep;
            const char* a2 = last ? nA : cA + (size_t)(t + 2) * kstep; const char* b2 = last ? nB : cB + (size_t)(t + 2) * kstep;
            const char* a3 = a2 + kstep; const char* b3 = b2 + kstep;
            PG8_LDB(B0, 0, 0); PG8_LDB(B1, 0, 1); PG8_SCHED; PG8_LDA(At, 0, 0); PG8_STAGE(PG8_SA(1, 1), a1 + hstep, voffA);
            PG8_WAIT_V(8); PG8_WAIT_L(0); PG8_BAR; PG8_MMA(0, 0, At, B0); PG8_MMA(0, 1, At, B1); PG8_BAR; PG8_SCHED;
            PG8_LDA(At, 0, 1); PG8_STAGE(PG8_SB(0, 0), b2, voffB); PG8_STAGE(PG8_SB(0, 1), b2 + hstep, voffB); PG8_STAGE(PG8_SA(0, 0), a2, voffA);
            PG8_WAIT_V(8); PG8_WAIT_L(0); PG8_BAR; PG8_MMA(1, 0, At, B0); PG8_MMA(1, 1, At, B1); PG8_BAR; PG8_SCHED;
            PG8_LDB(B0, 1, 0); PG8_LDB(B1, 1, 1); PG8_SCHED; PG8_LDA(At, 1, 0); PG8_STAGE(PG8_SA(0, 1), a2 + hstep, voffA);
            PG8_WAIT_V(8); PG8_WAIT_L(0); PG8_BAR; PG8_MMA(0, 0, At, B0); PG8_MMA(0, 1, At, B1); PG8_BAR; PG8_SCHED;
            PG8_LDA(At, 1, 1); PG8_STAGE(PG8_SB(1, 0), b3, voffB); PG8_STAGE(PG8_SB(1, 1), b3 + hstep, voffB); PG8_STAGE(PG8_SA(1, 0), a3, voffA);
            PG8_WAIT_V(8); PG8_WAIT_L(0); PG8_BAR; PG8_MMA(1, 0, At, B0); PG8_MMA(1, 1, At, B1); PG8_BAR; PG8_SCHED;
        }
        if constexpr (ALIGN_EPI) { if (wr == 0) PG8_BAR; }
        E(acc, cur, wr, wc, fr, fq);
        if (!has_next) break;
#pragma unroll
        for (int a = 0; a < 2; ++a)
#pragma unroll
            for (int b = 0; b < 2; ++b)
#pragma unroll
                for (int m = 0; m < 4; ++m)
#pragma unroll
                    for (int n = 0; n < 2; ++n) acc[a][b][m][n] = (f32x4){0.f, 0.f, 0.f, 0.f};
        cur = nxt; cA = nA; cB = nB; ++ui;
        if constexpr (ALIGN_EPI) { if (wr == 1) PG8_BAR; }
    }
    PG8_WAIT_V(0);
    if constexpr (!ALIGN_EPI) { if (wr == 0) PG8_BAR; }
    PG8_BAR;
#undef PG8_SA
#undef PG8_SB
#undef PG8_STAGE
#undef PG8_LDA
#undef PG8_LDB
#undef PG8_MMA
#undef PG8_WAIT_V
#undef PG8_WAIT_L
#undef PG8_BAR
#undef PG8_SCHED
}
}

namespace att {
constexpr int KROW = 144, KBUF = 64 * KROW;
constexpr int OFF_K = 0, OFF_V = 4 * KBUF, OFF_C = 8 * KBUF, OFF_LUT = OFF_C + SEQ * 4, LUT_N = 320, OFF_FLAG = OFF_LUT + LUT_N * 4;
constexpr int OFF_LUT_SWA = 12 * KBUF;
constexpr float DEAD = -136.f;
enum { M_SB = 0, M_SWA = 1, M_FOX = 2 };

__device__ __forceinline__ float other_half(float x, int hi) {
    const unsigned u = __float_as_uint(x); auto rr = __builtin_amdgcn_permlane32_swap(u, u, false, false);
    return __uint_as_float(hi ? rr[0] : rr[1]);
}
__device__ __forceinline__ f32x16 mfma32(bf16x8 a, bf16x8 b, f32x16 c) { return __builtin_amdgcn_mfma_f32_32x32x16_bf16(a, b, c, 0, 0, 0); }

__device__ __forceinline__ void pv_block(f32x16 (&o)[2], const f32x16& p, const LAS unsigned char* vb) {
#pragma unroll
    for (int j = 0; j < 2; ++j) {
        u32x4 pw; pw.x = cvt_pk(p[8 * j + 0], p[8 * j + 1]); pw.y = cvt_pk(p[8 * j + 2], p[8 * j + 3]); pw.z = cvt_pk(p[8 * j + 4], p[8 * j + 5]); pw.w = cvt_pk(p[8 * j + 6], p[8 * j + 7]);
        const bf16x8 pf = __builtin_bit_cast(bf16x8, pw);
#pragma unroll
        for (int db = 0; db < 2; ++db) { const bf16x8 vf = *(const LAS bf16x8*)(vb + db * 32 * KROW + j * 16); o[db] = mfma32(vf, pf, o[db]); }
    }
}
template <bool DIAG>
__device__ __forceinline__ void sb_block_t(f32x16& s, float& carry, int keybase, int tpos, int hi) {
    float tot = 0.f;
#pragma unroll
    for (int r = 15; r >= 0; --r) {
        const float z = s[r]; const float e = ex2(-z); const float L = lg2(1.f + e);
        const bool valid = !DIAG || (keybase + r < tpos);
        const float lsn = valid ? -(L + z) : 0.f;
        const float a = tot; tot += lsn; s[r] = valid ? (a - L) : -INFINITY;
    }
    const float other = other_half(tot, hi);
    const float base = carry + (hi ? 0.f : other);
#pragma unroll
    for (int r = 0; r < 16; ++r) s[r] = ex2(s[r] + base);
    carry += tot + other;
}
__device__ __forceinline__ void sb_block(f32x16& s, float& carry, int keybase, int tpos, bool diag, int hi) {
    if (diag) { asm volatile("" ::: "memory"); sb_block_t<true>(s, carry, keybase, tpos, hi); }
    else sb_block_t<false>(s, carry, keybase, tpos, hi);
}
__device__ __forceinline__ void sm_tile(f32x16& s0, f32x16& s1, f32x16 (&o)[2], float& m, float& l) {
    float t = fmaxf(s0[0], s1[0]);
#pragma unroll
    for (int r = 1; r < 16; ++r) t = fmaxf(t, fmaxf(s0[r], s1[r]));
    { const unsigned u = __float_as_uint(t); auto rr = __builtin_amdgcn_permlane32_swap(u, u, false, false); t = fmaxf(__uint_as_float(rr[0]), __uint_as_float(rr[1])); }
    const float mn = fmaxf(m, t); const float alpha = ex2(m - mn); m = mn; l *= alpha;
    if (__any(alpha != 1.f)) { o[0] *= alpha; o[1] *= alpha; }
    float sum = 0.f;
#pragma unroll
    for (int r = 0; r < 16; ++r) { s0[r] = ex2(s0[r] - mn); s1[r] = ex2(s1[r] - mn); sum += s0[r] + s1[r]; }
    l += sum;
}

template <int MODE>
__device__ __forceinline__ void attn_unit(LAS unsigned char* lds, const bf16_t* QKV, int ld, int qcol, int kcol, int vcol, bf16_t* OB, int ocol, int b, int qb, float sinkv, float kmax) {
    int tid = threadIdx.x; asm volatile("" : "+v"(tid));
    const int lane = tid & 63, w = __builtin_amdgcn_readfirstlane(tid >> 6), q32 = lane & 31, hi = lane >> 5;
    const int q0 = qb * 256, qw0 = q0 + 32 * w, tpos = qw0 + q32;
    const size_t rowb = (size_t)b * SEQ;
    bf16x8 qf[4];
    { const bf16_t* qp = QKV + (rowb + tpos) * ld + qcol + 8 * hi;
#pragma unroll
      for (int c = 0; c < 4; ++c) qf[c] = *(const bf16x8*)(qp + 16 * c); }
    const int skey = tid >> 3, sch = tid & 7;
    const bf16_t* kg = QKV + (rowb + skey) * ld + kcol + 8 * sch;
    const bf16_t* vg = QKV + (rowb + skey) * ld + vcol + 8 * sch;
    LAS unsigned char* Kb = lds + OFF_K; LAS unsigned char* Vb = lds + (MODE == M_SWA ? 6 * KBUF : OFF_V);
    const LAS float* carr = (const LAS float*)(lds + OFF_C); const LAS float* lut = (const LAS float*)(lds + OFF_LUT_SWA);
    const int kwr = skey * KROW + sch * 16, vwr2 = (8 * sch + 4 * (skey & 1)) * KROW + (skey & ~1) * 2;
    const int kperm = 16 * ((q32 >> 2) & 1) + 4 * (q32 >> 3) + (q32 & 3);
    const int krd = kperm * KROW + hi * 16, vrd = q32 * KROW + hi * 32;
    const int kt_hi = 4 * qb + 3, kt_lo = (MODE == M_SWA) ? (4 * qb - 2 > 0 ? 4 * qb - 2 : 0) : 0;

#define ATT_LOAD(KR, VR, t) do { KR = *(const u32x4*)(kg + (size_t)(t) * 64 * ld); VR = *(const u32x4*)(vg + (size_t)(t) * 64 * ld); } while (0)
    u32x4 kA, vA, kB, vB;
    if (MODE != M_SWA) { ATT_LOAD(kA, vA, kt_hi); ATT_LOAD(kB, vB, kt_hi - 1); }
    f32x16 o[2]; o[0] = (f32x16)(0.f); o[1] = (f32x16)(0.f);
    float carry = 0.f, m = (MODE == M_SWA) ? sinkv : -INFINITY, l = (MODE == M_SWA && hi == 0) ? 1.f : 0.f;
    float ct = 0.f, zb = 0.f;
    if (MODE == M_FOX) {
        float qq = 0.f;
#pragma unroll
        for (int c = 0; c < 4; ++c)
#pragma unroll
            for (int e = 0; e < 8; ++e) { const float x = __builtin_bit_cast(float, (unsigned)(unsigned short)qf[c][e] << 16); qq += x * x; }
        qq += __shfl_xor(qq, 32);
        zb = sqrtf(qq) * kmax * 1.002f + 0.01f; }
    volatile LAS unsigned* flag = (volatile LAS unsigned*)(lds + OFF_FLAG);
    if (MODE != M_SWA && tid == 0) { flag[0] = 0u; flag[1] = 0u; }
    bool wdead = false; unsigned dw0 = 0u, dw1 = 0u;

#define ATT_WRITE(buf, KR, VR) do { *(LAS u32x4*)(Kb + (buf) * KBUF + kwr) = KR; \
        const bool odd_ = (skey & 1) != 0; \
        const unsigned s0_ = odd_ ? VR.x : VR.z, s1_ = odd_ ? VR.y : VR.w; \
        const unsigned r0_ = (unsigned)__builtin_amdgcn_update_dpp(0, (int)s0_, 0x128, 0xf, 0xf, true), r1_ = (unsigned)__builtin_amdgcn_update_dpp(0, (int)s1_, 0x128, 0xf, 0xf, true); \
        const unsigned lo0_ = odd_ ? r0_ : VR.x, hi0_ = odd_ ? VR.z : r0_, lo1_ = odd_ ? r1_ : VR.y, hi1_ = odd_ ? VR.w : r1_; \
        LAS unsigned* vp_ = (LAS unsigned*)(Vb + (buf) * KBUF + vwr2); \
        vp_[0 * (KROW / 4)] = (lo0_ & 0xffffu) | (hi0_ << 16); vp_[1 * (KROW / 4)] = (lo0_ >> 16) | (hi0_ & 0xffff0000u); \
        vp_[2 * (KROW / 4)] = (lo1_ & 0xffffu) | (hi1_ << 16); vp_[3 * (KROW / 4)] = (lo1_ >> 16) | (hi1_ & 0xffff0000u); } while (0)
#define ATT_COMPUTE(kt_, cur_, par_) do { \
        const int k0 = (kt_) * 64; \
        bool active, diag; \
        if (MODE == M_SB) { active = k0 <= qw0 + 30; diag = k0 + 63 >= qw0; } \
        else if (MODE == M_FOX) { active = k0 <= qw0 + 31; diag = k0 + 63 > qw0; } \
        else { active = (k0 <= qw0 + 31) && (k0 + 63 >= qw0 - 127); diag = true; } \
        if (MODE == M_FOX && active && !wdead && !diag) { \
              \
            const float dmax = carr[k0 + 63];            \
            if (__all(dmax + zb - m <= DEAD)) { wdead = true; if (lane == 0) __hip_atomic_fetch_add((LAS unsigned*)(lds + OFF_FLAG) + (par_), 1u, __ATOMIC_RELAXED, __HIP_MEMORY_SCOPE_WORKGROUP); } \
        } \
        if (active && !wdead) { \
            const LAS unsigned char* kb_ = Kb + (cur_) * KBUF + krd; const LAS unsigned char* vb_ = Vb + (cur_) * KBUF + vrd; \
            f32x16 s0, s1; \
            if (MODE == M_FOX) { \
                  \
                const LAS f32x4* c0 = (const LAS f32x4*)(carr + k0 + 16 * hi); const LAS f32x4* c1 = (const LAS f32x4*)(carr + k0 + 32 + 16 * hi); \
                _Pragma("unroll") for (int i = 0; i < 4; ++i) { const f32x4 a = c0[i], bq = c1[i]; \
                    _Pragma("unroll") for (int j = 0; j < 4; ++j) { s0[4 * i + j] = a[j]; s1[4 * i + j] = bq[j]; } } \
            } else { s0 = (f32x16)(0.f); s1 = (f32x16)(0.f); } \
            _Pragma("unroll") for (int c = 0; c < 4; ++c) { \
                const bf16x8 k0f = *(const LAS bf16x8*)(kb_ + c * 32); const bf16x8 k1f = *(const LAS bf16x8*)(kb_ + 32 * KROW + c * 32); \
                s0 = mfma32(k0f, qf[c], s0); s1 = mfma32(k1f, qf[c], s1); } \
            const int kbase0 = k0 + 16 * hi, kbase1 = k0 + 32 + 16 * hi; \
            if (MODE == M_SB) { \
                sb_block(s1, carry, kbase1, tpos, diag, hi); \
                pv_block(o, s1, vb_ + 64); \
                sb_block(s0, carry, kbase0, tpos, diag, hi); \
                pv_block(o, s0, vb_); \
                  \
                if (__all(carry <= DEAD)) { wdead = true; if (lane == 0) __hip_atomic_fetch_add((LAS unsigned*)(lds + OFF_FLAG) + (par_), 1u, __ATOMIC_RELAXED, __HIP_MEMORY_SCOPE_WORKGROUP); } \
            } else { \
                if (MODE == M_SWA) { \
                    const LAS float* l0 = lut + (tpos - kbase0 + 64 - 15); const LAS float* l1 = lut + (tpos - kbase1 + 64 - 15); \
                    _Pragma("unroll") for (int r = 0; r < 16; ++r) { \
                        const int rel0 = tpos - (kbase0 + r), rel1 = tpos - (kbase1 + r); \
                        s0[r] = (rel0 >= 0 && rel0 < 128) ? s0[r] + l0[15 - r] : -INFINITY; \
                        s1[r] = (rel1 >= 0 && rel1 < 128) ? s1[r] + l1[15 - r] : -INFINITY; } \
                } else if (diag) { asm volatile("" ::: "memory");        \
                    _Pragma("unroll") for (int r = 0; r < 16; ++r) { if (kbase0 + r > tpos) s0[r] = -INFINITY; if (kbase1 + r > tpos) s1[r] = -INFINITY; } \
                } \
                sm_tile(s0, s1, o, m, l); \
                pv_block(o, s1, vb_ + 64); \
                pv_block(o, s0, vb_); \
            } \
        } } while (0)

#define ATT_COMPUTE2(kt_, sa_, sb_, par_) do { \
        const int k0a = (kt_) * 64, k0b = k0a - 64; \
        const bool diagA = (MODE == M_SB) ? (k0a + 63 >= qw0) : (k0a + 63 > qw0), diagB = (MODE == M_SB) ? (k0b + 63 >= qw0) : (k0b + 63 > qw0); \
        const bool fast = (MODE != M_SWA) && !wdead && (k0a <= qw0 + (MODE == M_SB ? 30 : 31));        \
        if (fast && MODE == M_FOX && !diagA) { \
            const float dmax = carr[k0a + 63]; \
            if (__all(dmax + zb - m <= DEAD)) { wdead = true; if (lane == 0) __hip_atomic_fetch_add((LAS unsigned*)(lds + OFF_FLAG) + (par_), 1u, __ATOMIC_RELAXED, __HIP_MEMORY_SCOPE_WORKGROUP); } \
        } \
        if (fast) { if (!wdead) { \
            const LAS unsigned char* kba = Kb + (sa_) * KBUF + krd; const LAS unsigned char* vba = Vb + (sa_) * KBUF + vrd; \
            const LAS unsigned char* kbb = Kb + (sb_) * KBUF + krd; const LAS unsigned char* vbb = Vb + (sb_) * KBUF + vrd; \
            f32x16 a0, a1, b0, b1; \
            if (MODE == M_FOX) { \
                const LAS f32x4* c0 = (const LAS f32x4*)(carr + k0a + 16 * hi); const LAS f32x4* c1 = (const LAS f32x4*)(carr + k0a + 32 + 16 * hi); \
                const LAS f32x4* d0 = (const LAS f32x4*)(carr + k0b + 16 * hi); const LAS f32x4* d1 = (const LAS f32x4*)(carr + k0b + 32 + 16 * hi); \
                _Pragma("unroll") for (int i = 0; i < 4; ++i) { const f32x4 x0 = c0[i], x1 = c1[i], y0 = d0[i], y1 = d1[i]; \
                    _Pragma("unroll") for (int j = 0; j < 4; ++j) { a0[4 * i + j] = x0[j]; a1[4 * i + j] = x1[j]; b0[4 * i + j] = y0[j]; b1[4 * i + j] = y1[j]; } } \
            } else { a0 = (f32x16)(0.f); a1 = (f32x16)(0.f); b0 = (f32x16)(0.f); b1 = (f32x16)(0.f); } \
            _Pragma("unroll") for (int c = 0; c < 4; ++c) { \
                const bf16x8 ka0 = *(const LAS bf16x8*)(kba + c * 32); const bf16x8 ka1 = *(const LAS bf16x8*)(kba + 32 * KROW + c * 32); \
                a0 = mfma32(ka0, qf[c], a0); a1 = mfma32(ka1, qf[c], a1); } \
            _Pragma("unroll") for (int c = 0; c < 4; ++c) { \
                const bf16x8 kb0 = *(const LAS bf16x8*)(kbb + c * 32); const bf16x8 kb1 = *(const LAS bf16x8*)(kbb + 32 * KROW + c * 32); \
                b0 = mfma32(kb0, qf[c], b0); b1 = mfma32(kb1, qf[c], b1); } \
            if (MODE == M_SB) { \
                sb_block(a1, carry, k0a + 32 + 16 * hi, tpos, diagA, hi); pv_block(o, a1, vba + 64); \
                sb_block(a0, carry, k0a + 16 * hi, tpos, diagA, hi); pv_block(o, a0, vba); \
                if (__all(carry <= DEAD)) { wdead = true; if (lane == 0) __hip_atomic_fetch_add((LAS unsigned*)(lds + OFF_FLAG) + (par_), 1u, __ATOMIC_RELAXED, __HIP_MEMORY_SCOPE_WORKGROUP); } \
                else { \
                    sb_block(b1, carry, k0b + 32 + 16 * hi, tpos, diagB, hi); pv_block(o, b1, vbb + 64); \
                    sb_block(b0, carry, k0b + 16 * hi, tpos, diagB, hi); pv_block(o, b0, vbb); \
                    if (__all(carry <= DEAD)) { wdead = true; if (lane == 0) __hip_atomic_fetch_add((LAS unsigned*)(lds + OFF_FLAG) + (par_), 1u, __ATOMIC_RELAXED, __HIP_MEMORY_SCOPE_WORKGROUP); } \
                } \
            } else { \
                if (diagA) { asm volatile("" ::: "memory"); const int ka0_ = k0a + 16 * hi, ka1_ = k0a + 32 + 16 * hi; \
                    _Pragma("unroll") for (int r = 0; r < 16; ++r) { if (ka0_ + r > tpos) a0[r] = -INFINITY; if (ka1_ + r > tpos) a1[r] = -INFINITY; } } \
                sm_tile(a0, a1, o, m, l); pv_block(o, a1, vba + 64); pv_block(o, a0, vba); \
                const float dmaxb = carr[k0b + 63]; \
                if (MODE == M_FOX && !diagB && __all(dmaxb + zb - m <= DEAD)) { wdead = true; if (lane == 0) __hip_atomic_fetch_add((LAS unsigned*)(lds + OFF_FLAG) + (par_), 1u, __ATOMIC_RELAXED, __HIP_MEMORY_SCOPE_WORKGROUP); } \
                else { \
                    if (diagB) { asm volatile("" ::: "memory"); const int kb0_ = k0b + 16 * hi, kb1_ = k0b + 32 + 16 * hi; \
                        _Pragma("unroll") for (int r = 0; r < 16; ++r) { if (kb0_ + r > tpos) b0[r] = -INFINITY; if (kb1_ + r > tpos) b1[r] = -INFINITY; } } \
                    sm_tile(b0, b1, o, m, l); pv_block(o, b1, vbb + 64); pv_block(o, b0, vbb); } \
            } \
        } } else { ATT_COMPUTE(kt_, sa_, par_); ATT_COMPUTE((kt_) - 1, sb_, par_); } \
    } while (0)

    if (MODE == M_SWA) {
        const int nt = kt_hi - kt_lo + 1;
        u32x4 kr[6], vr[6];
#pragma unroll
        for (int t = 0; t < 6; ++t) if (t < nt) ATT_LOAD(kr[t], vr[t], kt_lo + t);
#pragma unroll
        for (int t = 0; t < 6; ++t) if (t < nt) ATT_WRITE(t, kr[t], vr[t]);
        __syncthreads();
        for (int kt = kt_hi; kt >= kt_lo; --kt) { const int slot = kt - kt_lo; ATT_COMPUTE(kt, slot, 0); }
        __syncthreads();
    } else {
        ATT_WRITE(0, kA, vA); ATT_WRITE(1, kB, vB);
        ATT_LOAD(kA, vA, kt_hi - 2); ATT_LOAD(kB, vB, kt_hi - 3);
        __syncthreads();
        int kt = kt_hi;
        for (;;) {
            if (kt - 2 >= kt_lo) { ATT_WRITE(2, kA, vA); ATT_WRITE(3, kB, vB); if (kt - 4 >= kt_lo) { ATT_LOAD(kA, vA, kt - 4); ATT_LOAD(kB, vB, kt - 5); } }
            ATT_COMPUTE2(kt, 0, 1, 0);
            __syncthreads();
            dw0 = flag[0];
            if (dw0 + dw1 >= 8u) break;
            kt -= 2; if (kt < kt_lo) break;
            if (kt - 2 >= kt_lo) { ATT_WRITE(0, kA, vA); ATT_WRITE(1, kB, vB); if (kt - 4 >= kt_lo) { ATT_LOAD(kA, vA, kt - 4); ATT_LOAD(kB, vB, kt - 5); } }
            ATT_COMPUTE2(kt, 2, 3, 1);
            __syncthreads();
            dw1 = flag[1];
            if (dw0 + dw1 >= 8u) break;
            kt -= 2; if (kt < kt_lo) break;
        }
        __syncthreads();
    }
#undef ATT_LOAD
#undef ATT_WRITE
#undef ATT_COMPUTE
#undef ATT_COMPUTE2
    float inv = 1.f;
    if (MODE != M_SB) { const float lt = l + __shfl_xor(l, 32); inv = 1.f / lt; }
    {
        LAS unsigned char* stg = lds + w * (32 * KROW);
#pragma unroll
        for (int db = 0; db < 2; ++db)
#pragma unroll
            for (int a = 0; a < 4; ++a) { u32x2 wv; wv.x = cvt_pk(o[db][4 * a] * inv, o[db][4 * a + 1] * inv); wv.y = cvt_pk(o[db][4 * a + 2] * inv, o[db][4 * a + 3] * inv);
                *(LAS u32x2*)(stg + q32 * KROW + (32 * db + 8 * a + 4 * hi) * 2) = wv; }
        asm volatile("s_waitcnt lgkmcnt(0)" ::: "memory");
        bf16_t* ob = OB + (rowb + qw0) * D_MODEL + ocol;
#pragma unroll
        for (int i = 0; i < 4; ++i) { const int row = i * 8 + (lane >> 3), ch = lane & 7; const u32x4 v = *(const LAS u32x4*)(stg + row * KROW + ch * 16); *(u32x4*)(ob + (size_t)row * D_MODEL + ch * 8) = v; }
        __syncthreads();
    }
}

__device__ __forceinline__ int t5_bucket(int n) {
    if (n < 16) return n;
    int v = 16 + (int)(logf((float)n / 16.f) / 2.0794415416798357f * 16.f);
    return v < 31 ? v : 31;
}
}

constexpr size_t MiB = 1u << 20;
constexpr size_t WS_FFN_IN = 0, WS_FFN_OUT = 44 * MiB, WS_AB_IN = 66 * MiB, WS_AB_OUT = 70 * MiB + MiB / 2, WS_FOX_IN = 72 * MiB + MiB / 2, WS_FOX_OUT = 79 * MiB;
constexpr size_t WS_HB = 96 * MiB, WS_BIG = 160 * MiB, WS_OB = 352 * MiB, WS_F = 416 * MiB, WS_CTL = 419 * MiB, WS_XBUF = 420 * MiB, WS_LO = 421 * MiB, WS_END = 453 * MiB;
constexpr int CNT_OFF = 4096, CNT_WORDS = 6 * 128 * 64;
constexpr int LDS_X_OFF = 131072 + 1024;
constexpr int LDS_ST_OFF = 131072 + 320;
constexpr size_t FFN_IN_BYTES = 11 * MiB, FFN_OUT_BYTES = 5 * MiB + MiB / 2;
constexpr int LDS_BYTES = 147456;
constexpr int N_PHASES = 15;


#define XB_TMO      128
#define XB_XCNT(j)  (256  + 64 * (j))
#define XB_XSUB(j)  (1280 + 64 * (j))
#define XB_XGEN(j)  (2304 + 64 * (j))
#define XB_TOP      3328
#define XB_TOPGEN   3392
#define XCD_BAR_WORDS 3456
#define XB_SPIN_CAP (1u << 18)
__device__ __forceinline__ unsigned xb_ld(unsigned* p)              { return __hip_atomic_load(p, __ATOMIC_RELAXED, __HIP_MEMORY_SCOPE_AGENT); }
__device__ __forceinline__ unsigned xb_add(unsigned* p, unsigned v) { return __hip_atomic_fetch_add(p, v, __ATOMIC_RELAXED, __HIP_MEMORY_SCOPE_AGENT); }
__device__ __forceinline__ unsigned xb_xcc_id() { return (unsigned)__builtin_amdgcn_s_getreg((3 << 11) | 20) & 0xFu; }
#define XB_SPIN(cond, bar) do { unsigned _sp = 0; while (cond) { __builtin_amdgcn_s_sleep(1); \
    if ((++_sp & 255u) == 0u) { if (xb_ld(&(bar)[XB_TMO])) break; if (_sp > XB_SPIN_CAP) { atomicAdd(&(bar)[XB_TMO], 1u); break; } } } } while (0)
__device__ __forceinline__ void xcd_barrier_complete(unsigned* bar, unsigned x, unsigned& nloc, unsigned& nx) {
    const unsigned G = gridDim.x;
    unsigned sum, cnt, mine, sp = 0u;
    for (;;) {
        sum = 0u; cnt = 0u; mine = 0u;
#pragma unroll
        for (unsigned j = 0; j < 16; ++j) { const unsigned c = xb_ld(&bar[XB_XCNT(j)]); sum += c; cnt += (c > 0u) ? 1u : 0u; mine = (j == x) ? c : mine; }
        if (sum == G) break;
        __builtin_amdgcn_s_sleep(1);
        if ((++sp & 255u) == 0u) { if (xb_ld(&bar[XB_TMO])) break; if (sp > XB_SPIN_CAP) { atomicAdd(&bar[XB_TMO], 1u); break; } }
    }
    nloc = mine > 0u ? mine : 1u; nx = cnt > 0u ? cnt : 1u;
}
__device__ __forceinline__ void xcd_barrier(unsigned* bar, volatile LAS unsigned* st) {
    asm volatile("s_waitcnt vmcnt(0)" ::: "memory");
    __syncthreads();
    if (threadIdx.x == 0) {
        const unsigned x = xb_xcc_id();
        __builtin_amdgcn_s_waitcnt(0);
        unsigned nloc = st[0], nx = st[1];
        if (nloc == 0u) { xcd_barrier_complete(bar, x, nloc, nx); st[0] = nloc; st[1] = nx; }
        const unsigned old = xb_add(&bar[XB_XSUB(x)], 1u);
        const unsigned gen = old / nloc;
        if (old + 1u == (gen + 1u) * nloc) {
            __builtin_amdgcn_fence(__ATOMIC_RELEASE, "agent");
            asm volatile("s_waitcnt vmcnt(0)" ::: "memory");
            const unsigned og = xb_add(&bar[XB_TOP], 1u);
            const unsigned tg = og / nx;
            if (og + 1u == (tg + 1u) * nx) xb_add(&bar[XB_TOPGEN], 1u);
            else XB_SPIN(xb_ld(&bar[XB_TOPGEN]) == tg, bar);
            __builtin_amdgcn_fence(__ATOMIC_ACQUIRE, "agent");
            xb_add(&bar[XB_XGEN(x)], 1u);
            asm volatile("s_waitcnt vmcnt(0)" ::: "memory");
        } else {
            XB_SPIN(xb_ld(&bar[XB_XGEN(x)]) == gen, bar);
            __builtin_amdgcn_fence(__ATOMIC_ACQUIRE, "agent");
            asm volatile("s_waitcnt vmcnt(0)" ::: "memory");
        }
    }
    __syncthreads();
}

struct Args { const float* in[14]; float* out; unsigned char* ws; int ph_lo, ph_hi; };

__device__ __forceinline__ float wave_sum(float v) {
#pragma unroll
    for (int o = 1; o < 64; o <<= 1) v += __shfl_xor(v, o);
    return v;
}
__device__ __forceinline__ unsigned f2bf(float f) { unsigned u = __builtin_bit_cast(unsigned, f); return (u + 0x7fffu + ((u >> 16) & 1u)) >> 16; }
__device__ __forceinline__ unsigned pk2(float lo, float hi) { return f2bf(lo) | (f2bf(hi) << 16); }

__device__ __forceinline__ void transpose_item(const float* W, int ldw, int K, bf16_t* WT, int k0, int n0, int drow0, LAS float* scr, int lane) {
#pragma unroll
    for (int i = 0; i < 8; ++i) { const int idx = lane + 64 * i, kk = idx >> 3, c4 = idx & 7; const f32x4 v = *(const f32x4*)(W + (size_t)(k0 + kk) * ldw + n0 + 4 * c4);
        LAS float* d = scr + kk * 33 + 4 * c4; d[0] = v[0]; d[1] = v[1]; d[2] = v[2]; d[3] = v[3]; }
    asm volatile("s_waitcnt lgkmcnt(0)" ::: "memory");
    const int c = lane & 7;
#pragma unroll
    for (int j = 0; j < 4; ++j) { const int n = (lane >> 3) + 8 * j; const LAS float* s = scr + (8 * c) * 33 + n;
        u32x4 o; o.x = pk2(s[0 * 33], s[1 * 33]); o.y = pk2(s[2 * 33], s[3 * 33]); o.z = pk2(s[4 * 33], s[5 * 33]); o.w = pk2(s[6 * 33], s[7 * 33]);
        *(u32x4*)(WT + (size_t)(drow0 + n) * K + k0 + 8 * c) = o; }
    asm volatile("s_waitcnt lgkmcnt(0)" ::: "memory");
}

__global__ void __launch_bounds__(512, 2) mega(Args args) {
    extern __shared__ __attribute__((aligned(16))) unsigned char lds_raw[];
    LAS unsigned char* lds = (LAS unsigned char*)lds_raw;
    cg::grid_group grid = cg::this_grid();
    typedef const __attribute__((address_space(4))) Args* kargp_t;
    if (threadIdx.x < 2) ((volatile LAS unsigned*)(lds + LDS_ST_OFF))[threadIdx.x] = 0u;
    __syncthreads();

    for (int pp = args.ph_lo; pp < args.ph_hi; ++pp) {
        const int p = pp;
        int tid = threadIdx.x; asm volatile("" : "+v"(tid));
        int bid = blockIdx.x; asm volatile("" : "+s"(bid));
        int G = gridDim.x; asm volatile("" : "+s"(G));
        const int lane = tid & 63, wave = __builtin_amdgcn_readfirstlane(tid >> 6);
        const int gw = bid * 8 + wave, NGW = G * 8;
        kargp_t ap = (kargp_t)__builtin_amdgcn_kernarg_segment_ptr(); asm volatile("" : "+s"(ap));
        unsigned char* ws = ap->ws;
        bf16_t* HB = (bf16_t*)(ws + WS_HB); bf16_t* BIG = (bf16_t*)(ws + WS_BIG); bf16_t* OB = (bf16_t*)(ws + WS_OB); float* FB = (float*)(ws + WS_F);
        float* out = ap->out;
        if (EN_P0 && p == 0) {
            LAS float* scr = (LAS float*)(lds + wave * 16384);
            constexpr int I_IN = 16 * 176, I_OUT = 44 * 32, I_ABI = 16 * 72, I_O = 16 * 32, I_FXI = 16 * 96;
            constexpr int NITEMS = 4 * I_IN + 4 * I_OUT + I_ABI + I_O + I_FXI + I_O;
            for (int it = gw; it < NITEMS; it += NGW) {
                int r = it; const float* src; int ldw, K, nblk; bf16_t* dst; int mode = 0;
                if (r < 4 * I_IN) { const int idx = r / I_IN; r -= idx * I_IN; src = ap->in[(idx & 1) ? 5 : 3] + (size_t)(idx >> 1) * D_MODEL * 2 * D_FF; ldw = 2 * D_FF; K = D_MODEL; nblk = 176; dst = (bf16_t*)(ws + WS_FFN_IN + idx * FFN_IN_BYTES); mode = 1; }
                else if ((r -= 4 * I_IN) < 4 * I_OUT) { const int idx = r / I_OUT; r -= idx * I_OUT; src = ap->in[(idx & 1) ? 6 : 4] + (size_t)(idx >> 1) * D_FF * D_MODEL; ldw = D_MODEL; K = D_FF; nblk = 32; dst = (bf16_t*)(ws + WS_FFN_OUT + idx * FFN_OUT_BYTES); }
                else if ((r -= 4 * I_OUT) < I_ABI) { src = ap->in[7]; ldw = AB_IN; K = D_MODEL; nblk = 72; dst = (bf16_t*)(ws + WS_AB_IN); }
                else if ((r -= I_ABI) < I_O) { src = ap->in[8]; ldw = D_MODEL; K = D_MODEL; nblk = 32; dst = (bf16_t*)(ws + WS_AB_OUT); }
                else if ((r -= I_O) < I_FXI) { src = ap->in[10]; ldw = FOX_IN; K = D_MODEL; nblk = 96; dst = (bf16_t*)(ws + WS_FOX_IN); }
                else { r -= I_FXI; src = ap->in[12]; ldw = D_MODEL; K = D_MODEL; nblk = 32; dst = (bf16_t*)(ws + WS_FOX_OUT); }
                const int kb = r / nblk, nb = r - kb * nblk, n0 = 32 * nb;
                int drow0 = n0;
                if (mode == 1) { const int j = n0 < D_FF ? n0 : n0 - D_FF; drow0 = 256 * (j >> 7) + (j & 127) + (n0 < D_FF ? 0 : 128); }
                transpose_item(src, ldw, K, dst, 64 * kb, n0, drow0, scr, lane);
            }
            if (bid == 0) { unsigned* ctl = (unsigned*)(ws + WS_CTL); for (int i = tid; i < XCD_BAR_WORDS; i += 512) ctl[i] = 0u; }
            { unsigned* ctl = (unsigned*)(ws + WS_CTL) + CNT_OFF; for (int i = bid * 512 + tid; i < CNT_WORDS; i += G * 512) ctl[i] = 0u; }
            { bf16_t* dst = (bf16_t*)(ws + WS_FOX_IN); const float* src = ap->in[10];
              for (int i = bid * 512 + tid; i < 16 * D_MODEL; i += G * 512) { const int n = i >> 10, k = i & 1023; dst[(size_t)(FOX_QKV + n) * D_MODEL + k] = (bf16_t)f2bf(src[(size_t)k * FOX_IN + FOX_QKV + n]); } }
            for (int mrow = gw; mrow < MTOK; mrow += NGW) {
                const float* xr = ap->in[0] + (size_t)mrow * D_MODEL; bf16_t* hr = HB + (size_t)mrow * D_MODEL; unsigned char* lr = ws + WS_LO + (size_t)mrow * D_MODEL;
#pragma unroll
                for (int j = 0; j < 2; ++j) { const int c8 = 8 * (lane + 64 * j); u32x4 wv; u32x2 qv;
#pragma unroll
                    for (int n = 0; n < 2; ++n) { const f32x4 v = *(const f32x4*)(xr + c8 + 4 * n); const unsigned w0 = cvt_pk(v[0], v[1]), w1 = cvt_pk(v[2], v[3]);
                        const float l0 = (v[0] - __builtin_bit_cast(float, w0 << 16)) * 4096.f + 128.5f, l1 = (v[1] - __builtin_bit_cast(float, w0 & 0xffff0000u)) * 4096.f + 128.5f;
                        const float l2 = (v[2] - __builtin_bit_cast(float, w1 << 16)) * 4096.f + 128.5f, l3 = (v[3] - __builtin_bit_cast(float, w1 & 0xffff0000u)) * 4096.f + 128.5f;
                        const unsigned q = (unsigned)(int)fminf(fmaxf(l0, 0.f), 255.f) | ((unsigned)(int)fminf(fmaxf(l1, 0.f), 255.f) << 8) | ((unsigned)(int)fminf(fmaxf(l2, 0.f), 255.f) << 16) | ((unsigned)(int)fminf(fmaxf(l3, 0.f), 255.f) << 24);
                        if (n == 0) { wv.x = w0; wv.y = w1; qv.x = q; } else { wv.z = w0; wv.w = w1; qv.y = q; } }
                    *(u32x4*)(hr + c8) = wv; *(u32x2*)(lr + c8) = qv; }
            }
        } else {
            const int L = (p - 1) / 7, s = (p - 1) % 7;
            if (EN_G1 && (s == 0 || s == 5)) {
                const int idx = L * 2 + (s == 5 ? 1 : 0);
                pg8::Gemm g{HB, (const bf16_t*)(ws + WS_FFN_IN + idx * FFN_IN_BYTES), MTOK, 2 * D_FF, D_MODEL};
                pg8::StaticOrder S; S.init(MTOK, 2 * D_FF, G, bid, WGM_FFN_IN);
                pg8::EpiSwiGLU E{BIG, D_FF};
                pg8::gemm_phase<pg8::EpiSwiGLU, pg8::StaticOrder>(lds, g, S, E);
            } else if (EN_G2 && (s == 1 || s == 4 || s == 6)) {
                const bf16_t* A; const bf16_t* Bt; int K; float cs;
                const int li = L * 3 + (s == 1 ? 0 : (s == 4 ? 1 : 2));
                if (s == 4) { A = OB; Bt = (const bf16_t*)(ws + (L == 0 ? WS_AB_OUT : WS_FOX_OUT)); K = D_MODEL; cs = 1.f; }
                else { const int idx = L * 2 + (s == 6 ? 1 : 0); A = BIG; Bt = (const bf16_t*)(ws + WS_FFN_OUT + idx * FFN_OUT_BYTES); K = D_FF; cs = 0.5f; }
                pg8::Gemm g{A, Bt, MTOK, D_MODEL, K};
                pg8::StaticOrder S; S.init(MTOK, D_MODEL, G, bid, WGM_OUT);
                pg8::EpiLnFused E{(L == 1 && s == 6) ? out : (float*)nullptr, HB, ws + WS_LO, ALPHA, cs, ap->in[1] + (size_t)li * D_MODEL, ap->in[2] + (size_t)li * D_MODEL,
                                  (unsigned long long*)(ws + WS_XBUF), (unsigned*)(ws + WS_CTL) + CNT_OFF + li * 128 * 64, lds + LDS_X_OFF};
                pg8::gemm_phase<pg8::EpiLnFused, pg8::StaticOrder>(lds, g, S, E);
            } else if (EN_G3 && s == 2) {
                const bool ab = (L == 0);
                if (!ab) {
                    const bf16_t* wf = (const bf16_t*)(ws + WS_FOX_IN) + (size_t)FOX_QKV * D_MODEL;
                    for (int task = gw; task < MTOK / 16; task += NGW) {
                        const bf16_t* ap_ = HB + (size_t)(task * 16 + (lane & 15)) * D_MODEL + 8 * (lane >> 4); const bf16_t* bp_ = wf + (size_t)(lane & 15) * D_MODEL + 8 * (lane >> 4);
                        f32x4 fa = (f32x4){0.f, 0.f, 0.f, 0.f};
#pragma unroll 8
                        for (int k = 0; k < D_MODEL; k += 32) fa = __builtin_amdgcn_mfma_f32_16x16x32_bf16(*(const bf16x8*)(ap_ + k), *(const bf16x8*)(bp_ + k), fa, 0, 0, 0);
#pragma unroll
                        for (int r = 0; r < 4; ++r) FB[(size_t)(task * 16 + 4 * (lane >> 4) + r) * 16 + (lane & 15)] = fa[r];
                    }
                }
                pg8::Gemm g{HB, (const bf16_t*)(ws + (ab ? WS_AB_IN : WS_FOX_IN)), MTOK, ab ? AB_IN : FOX_QKV, D_MODEL};
                pg8::StaticOrder S; S.init(MTOK, g.N, G, bid, WGM_QKV);
                pg8::EpiQKV E{BIG, ab ? AB_IN : FOX_QKV, ab ? 0xC3u : 0xFu, FB, -1};
                pg8::gemm_phase<pg8::EpiQKV, pg8::StaticOrder>(lds, g, S, E);
            } else if (s == 3) {
                if (L == 0) {
                    for (int job = bid; job < 256; job += G) {
                        if (EN_SB) { const int bh = job >> 1, which = job & 1, b = bh >> 3, h = bh & 7;
                          for (int i = 0; i < 4; ++i) { const int qb = which ? (i == 0 ? 6 : i == 1 ? 5 : i == 2 ? 2 : 1) : (i == 0 ? 7 : i == 1 ? 4 : i == 2 ? 3 : 0);
                              att::attn_unit<att::M_SB>(lds, BIG, AB_IN, h * 64, 512 + h * 64, 1024 + h * 64, OB, h * 64, b, qb, 0.f, 0.f); } }
                        if (EN_SWA) for (int i = 0; i < 4; ++i) { const int idx = job * 4 + i, qb = idx & 7, hq = (idx >> 3) & 7, b = idx >> 6;
                            LAS float* lut = (LAS float*)(lds + att::OFF_LUT_SWA);
                            if (tid < att::LUT_N) { const int rel = tid - 64; lut[tid] = (rel >= 0 && rel < 128) ? ap->in[13][att::t5_bucket(rel) * 8 + hq] * LOG2E : 0.f; }
                            const float sinkv = ap->in[9][hq] * LOG2E;
                            att::attn_unit<att::M_SWA>(lds, BIG, AB_IN, 1536 + hq * 64, 2048 + (hq >> 2) * 64, 2176 + (hq >> 2) * 64, OB, 512 + hq * 64, b, qb, sinkv, 0.f); }
                    }
                } else {
                    if (EN_FOX) for (int job = bid; job < 256; job += G) {
                        const int b = job >> 4, h = job & 15;
                        LAS float* carr = (LAS float*)(lds + att::OFF_C); LAS float* wsum = (LAS float*)(lds + att::OFF_LUT);
                        const float bfh = ap->in[11][h];
                        float v[4];
#pragma unroll
                        for (int i = 0; i < 4; ++i) { const float f = FB[((size_t)b * SEQ + tid * 4 + i) * 16 + h] + bfh; v[i] = (fminf(f, 0.f) - log1pf(expf(-fabsf(f)))) * LOG2E; }
                        v[1] += v[0]; v[2] += v[1]; v[3] += v[2];
                        float x = v[3];
#pragma unroll
                        for (int o = 1; o < 64; o <<= 1) { const float y = __shfl_up(x, o); if (lane >= o) x += y; }
                        float excl = __shfl_up(x, 1); if (lane == 0) excl = 0.f;
                        float kn = 0.f;
                        for (int i = 0; i < 4; ++i) { const u32x4* kp = (const u32x4*)(BIG + ((size_t)b * SEQ + tid * 4 + i) * FOX_QKV + 1024 + h * 64); float ss = 0.f;
#pragma unroll
                            for (int c = 0; c < 8; ++c) { const u32x4 kv = kp[c];
#pragma unroll
                                for (int e = 0; e < 4; ++e) { const float lo = __builtin_bit_cast(float, kv[e] << 16), hi2 = __builtin_bit_cast(float, kv[e] & 0xffff0000u); ss += lo * lo + hi2 * hi2; } }
                            kn = fmaxf(kn, ss); }
#pragma unroll
                        for (int o = 1; o < 64; o <<= 1) kn = fmaxf(kn, __shfl_xor(kn, o));
                        if (lane == 63) { wsum[wave] = x; wsum[8 + wave] = kn; }
                        __syncthreads();
                        float woff = 0.f, kmax = 0.f;
                        for (int i = 0; i < wave; ++i) woff += wsum[i];
                        for (int i = 0; i < 8; ++i) kmax = fmaxf(kmax, wsum[8 + i]);
                        kmax = sqrtf(kmax);
#pragma unroll
                        for (int i = 0; i < 4; ++i) carr[tid * 4 + i] = -(v[i] + excl + woff);
                        __syncthreads();
                        for (int qb = 7; qb >= 0; --qb)
                            att::attn_unit<att::M_FOX>(lds, BIG, FOX_QKV, h * 64, 1024 + h * 64, 2048 + h * 64, OB, h * 64, b, qb, 0.f, kmax);
                        __syncthreads();
                    }
                }
            }
        }
        if (pp + 1 < args.ph_hi) {
            if (pp == 0) { grid.sync();
                if (threadIdx.x == 0) (void)xb_add((unsigned*)(ap->ws + WS_CTL) + XB_XCNT(xb_xcc_id()), 1u); }
            else xcd_barrier((unsigned*)(ap->ws + WS_CTL), (volatile LAS unsigned*)(lds + LDS_ST_OFF));
        }
    }
}

extern "C" void kernel_launch(void* const* d_in, const int* in_sizes, int n_in, void* d_out, int out_size, void* d_ws, size_t ws_size, hipStream_t stream) {
    static int grid = 0;
    if (grid == 0) {
        if (n_in != 14 || out_size != MTOK * D_MODEL || ws_size < WS_END) { fprintf(stderr, "kernel_launch: unexpected problem (n_in %d, out %d, ws %zu)\n", n_in, out_size, ws_size); grid = -1; return; }
        int dev = 0, cus = 0, per_cu = 0;
        hipGetDevice(&dev); hipDeviceGetAttribute(&cus, hipDeviceAttributeMultiprocessorCount, dev);
        if (hipFuncSetAttribute((const void*)mega, hipFuncAttributeMaxDynamicSharedMemorySize, LDS_BYTES) != hipSuccess) { fprintf(stderr, "kernel_launch: hipFuncSetAttribute failed\n"); grid = -1; return; }
        if (hipOccupancyMaxActiveBlocksPerMultiprocessor(&per_cu, (const void*)mega, 512, LDS_BYTES) != hipSuccess || per_cu < 1) per_cu = 1;
        (void)hipGetLastError();
        grid = cus * per_cu;
        if (grid > 256) grid = 256;
        if (grid != 256) { fprintf(stderr, "kernel_launch: the fused LayerNorm epilogues need exactly 256 resident workgroups (got %d); nothing launched\n", grid); grid = -1; return; }
    }
    if (grid < 0) return;
    Args a{};
    for (int i = 0; i < 14; ++i) a.in[i] = (const float*)d_in[i];
    a.out = (float*)d_out; a.ws = (unsigned char*)d_ws;
#if MK_N_LAUNCHES == 1
    a.ph_lo = 0; a.ph_hi = N_PHASES;
    void* kargs[] = {&a};
    hipError_t e = hipLaunchCooperativeKernel((const void*)mega, dim3(grid), dim3(512), kargs, LDS_BYTES, stream);
    if (e != hipSuccess) fprintf(stderr, "cooperative launch failed: %s (grid %d)\n", hipGetErrorString(e), grid);
#else
    for (int p = 0; p < N_PHASES; ++p) { a.ph_lo = p; a.ph_hi = p + 1; hipLaunchKernelGGL(mega, dim3(grid), dim3(512), LDS_BYTES, stream, a); }
#endif
}
```

```cpp
#include <hip/hip_runtime.h>
#include <hip/hip_cooperative_groups.h>
#include <cstdint>
#include <cstdio>
#include <cmath>
namespace cg = cooperative_groups;

#ifndef MK_N_LAUNCHES
#define MK_N_LAUNCHES 1
#endif

#ifndef EN_P0
#define EN_P0 1
#endif
#ifndef EN_G1
#define EN_G1 1
#endif
#ifndef EN_G2
#define EN_G2 1
#endif
#ifndef EN_LN
#define EN_LN 1
#endif
#ifndef EN_G3
#define EN_G3 1
#endif
#ifndef EN_SB
#define EN_SB 1
#endif
#ifndef EN_SWA
#define EN_SWA 1
#endif
#ifndef EN_FOX
#define EN_FOX 1
#endif
#ifndef WGM_FFN_IN
#define WGM_FFN_IN 4
#endif
#ifndef WGM_OUT
#define WGM_OUT 4
#endif
#ifndef WGM_QKV
#define WGM_QKV 4
#endif
#define LAS __attribute__((address_space(3)))
typedef unsigned short bf16_t;
typedef short bf16x8 __attribute__((ext_vector_type(8)));
typedef float f32x2 __attribute__((ext_vector_type(2)));
typedef float f32x4 __attribute__((ext_vector_type(4)));
typedef float f32x16 __attribute__((ext_vector_type(16)));
typedef unsigned u32x2 __attribute__((ext_vector_type(2)));
typedef unsigned u32x4 __attribute__((ext_vector_type(4)));
typedef __bf16 bf16x2_t __attribute__((ext_vector_type(2)));

constexpr int D_MODEL = 1024, BATCH = 16, SEQ = 2048, MTOK = BATCH * SEQ, D_FF = 2816;
constexpr int AB_IN = 2304, FOX_QKV = 3072, FOX_IN = 3088, FOX_NPAD = 3328;
constexpr float LOG2E = 1.4426950408889634f;
constexpr float QSCALE = 0.125f * LOG2E;
constexpr float ALPHA = 1.4142135623730951f;
constexpr float LN_EPS = 1e-5f;

__device__ __forceinline__ unsigned cvt_pk(float lo, float hi) { f32x2 v = {lo, hi}; bf16x2_t b = __builtin_convertvector(v, bf16x2_t); return __builtin_bit_cast(unsigned, b); }
__device__ __forceinline__ float ex2(float x) { return __builtin_amdgcn_exp2f(x); }
__device__ __forceinline__ float lg2(float x) { return __builtin_amdgcn_logf(x); }

namespace pg8 {
constexpr int BM = 256, BK = 64, HALF = 128, HTB = HALF * BK * 2, STAGE_BYTES = 8 * HTB, NXCD = 8;
__host__ __device__ __forceinline__ int lds_byte(int r, int c) { const int st = (r >> 4) * 2 + (c >> 5), rr = r & 15, cc = c & 31, ob = rr * 64 + cc * 2; return st * 1024 + (ob ^ (((ob >> 9) & 1) << 5)); }
__host__ __device__ __forceinline__ void stage_rc(int b, int& R, int& C) { const int st = b / 1024, sb = b % 1024, swz = sb ^ (((sb >> 9) & 1) << 5); R = (st >> 1) * 16 + swz / 64; C = (st & 1) * 32 + (swz % 64) / 2; }
__host__ __device__ __forceinline__ int perm32(int rho) { const int n = rho >> 4, i = rho & 15; return 8 * (i >> 2) + 4 * n + (i & 3); }

struct Unit { int pm, pn; };
struct Gemm { const bf16_t* A; const bf16_t* Bt; int M, N, K; };

struct StaticOrder {
    int nM, nN, nwg, G, c, WGM;
    __host__ __device__ void init(int M, int N, int G_, int c_, int wgm_) { nM = M / BM; nN = N / BM; nwg = nM * nN; G = G_; c = c_; WGM = wgm_; }
    __host__ __device__ bool next(int i, Unit& u) const {
        const long L = (long)i * G + c; if (L >= nwg) return false;
        int wgid = (int)L; { const int q = nwg / NXCD, r = nwg % NXCD, xcd = wgid % NXCD, off = wgid / NXCD; wgid = (xcd < r ? xcd * (q + 1) : r * (q + 1) + (xcd - r) * q) + off; }
        const int nig = WGM * nN, gid = wgid / nig, fm = gid * WGM, gsz = (nM - fm) < WGM ? (nM - fm) : WGM;
        u.pm = fm + ((wgid % nig) % gsz); u.pn = (wgid % nig) / gsz; return true;
    }
};

struct EpiSwiGLU {
    static constexpr bool PERM = true;
    bf16_t* O; int ldc;
    __device__ __forceinline__ void operator()(const f32x4 (&acc)[2][2][4][2], const Unit& u, int wr, int wc, int fr, int fq) const {
        const int row0 = u.pm * BM + wr * 64 + fr; const int col0 = u.pn * HALF + wc * 32 + 8 * fq;
#pragma unroll
        for (int ai = 0; ai < 2; ++ai)
#pragma unroll
            for (int m = 0; m < 4; ++m) {
                bf16_t* rowp = O + (size_t)(row0 + ai * HALF + m * 16) * ldc + col0;
                float v[8];
#pragma unroll
                for (int n = 0; n < 2; ++n)
#pragma unroll
                    for (int j = 0; j < 4; ++j) { const float g = acc[ai][0][m][n][j], up = acc[ai][1][m][n][j];
                        v[n * 4 + j] = g * __builtin_amdgcn_rcpf(1.f + ex2(-LOG2E * g)) * up; }
                u32x4 w; w.x = cvt_pk(v[0], v[1]); w.y = cvt_pk(v[2], v[3]); w.z = cvt_pk(v[4], v[5]); w.w = cvt_pk(v[6], v[7]);
                *(u32x4*)rowp = w;
            }
    }
};
struct EpiQKV {
    static constexpr bool PERM = true;
    bf16_t* O; int ldc; unsigned qmask; float* F; int ftile;
    __device__ __forceinline__ void operator()(const f32x4 (&acc)[2][2][4][2], const Unit& u, int wr, int wc, int fr, int fq) const {
        const int row0 = u.pm * BM + wr * 64 + fr;
        if (u.pn == ftile) {
            if (wc == 0 && fq < 2) {
#pragma unroll
                for (int ai = 0; ai < 2; ++ai)
#pragma unroll
                    for (int m = 0; m < 4; ++m) { float* fp = F + (size_t)(row0 + ai * HALF + m * 16) * 16 + 8 * fq; *(f32x4*)fp = acc[ai][0][m][0]; *(f32x4*)(fp + 4) = acc[ai][0][m][1]; }
            }
            return;
        }
        const float sc = ((qmask >> u.pn) & 1u) ? QSCALE : 1.f;
        const int col0 = u.pn * BM + wc * 32 + 8 * fq;
#pragma unroll
        for (int ai = 0; ai < 2; ++ai)
#pragma unroll
            for (int m = 0; m < 4; ++m) { bf16_t* rowp = O + (size_t)(row0 + ai * HALF + m * 16) * ldc + col0;
#pragma unroll
                for (int bj = 0; bj < 2; ++bj) { const f32x4 v0 = acc[ai][bj][m][0] * sc, v1 = acc[ai][bj][m][1] * sc;
                    u32x4 w; w.x = cvt_pk(v0[0], v0[1]); w.y = cvt_pk(v0[2], v0[3]); w.z = cvt_pk(v1[0], v1[1]); w.w = cvt_pk(v1[2], v1[3]);
                    *(u32x4*)(rowp + bj * HALF) = w; } }
    }
};
struct EpiLnFused {
    static constexpr bool PERM = true;
    float* out32; bf16_t* hb; unsigned char* lob; float alpha, cs; const float* g; const float* b;
    unsigned long long* xbuf; unsigned* cnt; LAS unsigned char* xl;
    __device__ __forceinline__ void operator()(f32x4 (&acc)[2][2][4][2], const Unit& u, int wr, int wc, int fr, int fq) const {
        const int col0 = u.pn * BM + wc * 32 + 8 * fq; const int wid = wr * 4 + wc, lane = fq * 16 + fr, tid = wid * 64 + lane;
        LAS f32x2* P = (LAS f32x2*)xl; LAS f32x2* S = (LAS f32x2*)(xl + 8192); volatile LAS unsigned* flag = (volatile LAS unsigned*)(xl + 8192 + 2048);
        {
        const bf16_t* hbp = hb; const unsigned char* lobp = lob;
#pragma unroll
        for (int ai = 0; ai < 2; ++ai) {
            u32x4 hv[4][2]; u32x2 lv[4][2];
#pragma unroll
            for (int m = 0; m < 4; ++m) { const size_t off = (size_t)(u.pm * BM + ai * HALF + wr * 64 + m * 16 + fr) * D_MODEL + col0;
#pragma unroll
                for (int bj = 0; bj < 2; ++bj) { hv[m][bj] = *(const u32x4*)(hbp + off + bj * HALF); lv[m][bj] = *(const u32x2*)(lobp + off + bj * HALF); } }
#pragma unroll
            for (int m = 0; m < 4; ++m) {
#pragma unroll
                for (int bj = 0; bj < 2; ++bj)
#pragma unroll
                    for (int n = 0; n < 2; ++n) { const unsigned h0 = n ? hv[m][bj].z : hv[m][bj].x, h1 = n ? hv[m][bj].w : hv[m][bj].y; const unsigned lw = n ? lv[m][bj].y : lv[m][bj].x; f32x4 r;
                        r[0] = __builtin_bit_cast(float, h0 << 16) - 0.03125f + (float)(lw & 0xffu) * 0.000244140625f;
                        r[1] = __builtin_bit_cast(float, h0 & 0xffff0000u) - 0.03125f + (float)((lw >> 8) & 0xffu) * 0.000244140625f;
                        r[2] = __builtin_bit_cast(float, h1 << 16) - 0.03125f + (float)((lw >> 16) & 0xffu) * 0.000244140625f;
                        r[3] = __builtin_bit_cast(float, h1 & 0xffff0000u) - 0.03125f + (float)(lw >> 24) * 0.000244140625f;
                        acc[ai][bj][m][n] = r * alpha + acc[ai][bj][m][n] * cs; }
                asm volatile("" : "+v"(acc[ai][0][m][0]), "+v"(acc[ai][0][m][1]), "+v"(acc[ai][1][m][0]), "+v"(acc[ai][1][m][1])); }
            asm volatile("" : "+s"(hbp), "+s"(lobp) : "v"(acc[ai][1][3][1][3]) : "memory");
        }
        }
#pragma unroll
        for (int ai = 0; ai < 2; ++ai)
#pragma unroll
            for (int m = 0; m < 4; ++m) {
                float s1 = 0.f, s2 = 0.f;
#pragma unroll
                for (int bj = 0; bj < 2; ++bj)
#pragma unroll
                    for (int n = 0; n < 2; ++n) { const f32x4 x = acc[ai][bj][m][n]; s1 += (x[0] + x[1]) + (x[2] + x[3]); s2 += (x[0] * x[0] + x[1] * x[1]) + (x[2] * x[2] + x[3] * x[3]); }
                s1 += __shfl_xor(s1, 16); s1 += __shfl_xor(s1, 32); s2 += __shfl_xor(s2, 16); s2 += __shfl_xor(s2, 32);
                if (fq == 0) P[(ai * HALF + wr * 64 + m * 16 + fr) * 4 + wc] = (f32x2){s1, s2};
                __builtin_amdgcn_sched_barrier(0);
            }
        asm volatile("s_waitcnt lgkmcnt(0)" ::: "memory"); __builtin_amdgcn_s_barrier(); asm volatile("" ::: "memory");
        unsigned* pc = cnt + 64 * u.pm;
        if (tid < 256) { const f32x2 a = P[tid * 4 + 0], bq = P[tid * 4 + 1], c = P[tid * 4 + 2], d = P[tid * 4 + 3];
            const float t1 = (a.x + bq.x) + (c.x + d.x), t2 = (a.y + bq.y) + (c.y + d.y);
            __hip_atomic_store(xbuf + ((size_t)(u.pm * BM + tid) * 4 + u.pn), ((unsigned long long)__float_as_uint(t2) << 32) | __float_as_uint(t1), __ATOMIC_RELAXED, __HIP_MEMORY_SCOPE_AGENT); }
        asm volatile("s_waitcnt vmcnt(0)" ::: "memory");
        if (wid < 4 && lane == 0) __hip_atomic_fetch_add(pc, 1u, __ATOMIC_RELAXED, __HIP_MEMORY_SCOPE_AGENT);
        if (wid == 0) {
            for (unsigned sp = 0; sp < (1u << 20); ++sp) {
                if ((unsigned)__builtin_amdgcn_readfirstlane(__hip_atomic_load(pc, __ATOMIC_RELAXED, __HIP_MEMORY_SCOPE_AGENT)) >= 16u) break;
                __builtin_amdgcn_s_sleep(2);
            }
            __builtin_amdgcn_fence(__ATOMIC_ACQUIRE, "agent");
            if (lane == 0) flag[0] = 1u;
        }
        asm volatile("s_waitcnt vmcnt(0) lgkmcnt(0)" ::: "memory"); __builtin_amdgcn_s_barrier(); asm volatile("" ::: "memory");
        if (tid < 256) { const unsigned long long* slot = xbuf + (size_t)(u.pm * BM + tid) * 4; float t1 = 0.f, t2 = 0.f;
#pragma unroll
            for (int t = 0; t < 4; ++t) { const unsigned long long w = __hip_atomic_load(slot + t, __ATOMIC_RELAXED, __HIP_MEMORY_SCOPE_AGENT); t1 += __uint_as_float((unsigned)w); t2 += __uint_as_float((unsigned)(w >> 32)); }
            const float mean = t1 * (1.f / D_MODEL); const float var = fmaxf(t2 * (1.f / D_MODEL) - mean * mean, 0.f);
            S[tid] = (f32x2){mean, 1.f / sqrtf(var + LN_EPS)}; }
        asm volatile("s_waitcnt lgkmcnt(0)" ::: "memory"); __builtin_amdgcn_s_barrier(); asm volatile("" ::: "memory");
        f32x4 gv[2][2], bv[2][2];
#pragma unroll
        for (int bj = 0; bj < 2; ++bj)
#pragma unroll
            for (int n = 0; n < 2; ++n) { gv[bj][n] = *(const f32x4*)(g + col0 + bj * HALF + n * 4); bv[bj][n] = *(const f32x4*)(b + col0 + bj * HALF + n * 4); }
        if (out32) {
#pragma unroll
        for (int ai = 0; ai < 2; ++ai)
#pragma unroll
            for (int m = 0; m < 4; ++m) { const int rt = ai * HALF + wr * 64 + m * 16 + fr; const f32x2 st = S[rt]; const size_t off = (size_t)(u.pm * BM + rt) * D_MODEL + col0;
#pragma unroll
                for (int bj = 0; bj < 2; ++bj)
#pragma unroll
                    for (int n = 0; n < 2; ++n) *(f32x4*)(out32 + off + bj * HALF + n * 4) = (acc[ai][bj][m][n] - st.x) * st.y * gv[bj][n] + bv[bj][n];
                __builtin_amdgcn_sched_barrier(0); }
        } else {
#pragma unroll
        for (int ai = 0; ai < 2; ++ai)
#pragma unroll
            for (int m = 0; m < 4; ++m) { const int rt = ai * HALF + wr * 64 + m * 16 + fr; const f32x2 st = S[rt]; const size_t off = (size_t)(u.pm * BM + rt) * D_MODEL + col0;
#pragma unroll
                for (int bj = 0; bj < 2; ++bj) { u32x4 wv; u32x2 qv;
#pragma unroll
                    for (int n = 0; n < 2; ++n) { const f32x4 y = (acc[ai][bj][m][n] - st.x) * st.y * gv[bj][n] + bv[bj][n];
                        const unsigned w0 = cvt_pk(y[0], y[1]), w1 = cvt_pk(y[2], y[3]);
                        const float l0 = (y[0] - __builtin_bit_cast(float, w0 << 16)) * 4096.f + 128.5f, l1 = (y[1] - __builtin_bit_cast(float, w0 & 0xffff0000u)) * 4096.f + 128.5f;
                        const float l2 = (y[2] - __builtin_bit_cast(float, w1 << 16)) * 4096.f + 128.5f, l3 = (y[3] - __builtin_bit_cast(float, w1 & 0xffff0000u)) * 4096.f + 128.5f;
                        const unsigned q = (unsigned)(int)fminf(fmaxf(l0, 0.f), 255.f) | ((unsigned)(int)fminf(fmaxf(l1, 0.f), 255.f) << 8) | ((unsigned)(int)fminf(fmaxf(l2, 0.f), 255.f) << 16) | ((unsigned)(int)fminf(fmaxf(l3, 0.f), 255.f) << 24);
                        if (n == 0) { wv.x = w0; wv.y = w1; qv.x = q; } else { wv.z = w0; wv.w = w1; qv.y = q; } }
                    *(u32x4*)(hb + off + bj * HALF) = wv; *(u32x2*)(lob + off + bj * HALF) = qv; }
                __builtin_amdgcn_sched_barrier(0); }
        }
    }
};

template <class Epi, class Sched, bool ALIGN_EPI = true>
__device__ __forceinline__ void gemm_phase(LAS unsigned char* lds, const Gemm g, const Sched& S, const Epi& E) {
    int tid = threadIdx.x; asm volatile("" : "+v"(tid));
    const int wid = __builtin_amdgcn_readfirstlane(tid >> 6), lane = tid & 63, wr = wid >> 2, wc = wid & 3, fr = lane & 15, fq = lane >> 4;
    const int K = g.K, nt = K / BK;
    unsigned voffA[2], voffB[2];
#pragma unroll
    for (int i = 0; i < 2; ++i) { int R, C; stage_rc(tid * 16 + i * 8192, R, C); const int Rb = Epi::PERM ? ((R & ~31) + perm32(R & 31)) : R;
        voffA[i] = (unsigned)(R * K + C) * 2u; voffB[i] = (unsigned)(Rb * K + C) * 2u; }
    const size_t kstep = (size_t)(BK * 2);
    const size_t hstep = (size_t)HALF * K * 2;
    const size_t tstep = 2 * hstep;
    const unsigned ldsw = (unsigned)wid * 1024u;
    const int aoff = lds_byte(wr * 64 + fr, fq * 8), boff = lds_byte(wc * 32 + fr, fq * 8);
#define PG8_SA(b, h) (((b) * 2 + (h)) * HTB)
#define PG8_SB(b, h) ((4 + (b) * 2 + (h)) * HTB)
#define PG8_STAGE(bufoff, gbase, voff) do { _Pragma("unroll") for (int _i = 0; _i < 2; ++_i) \
        __builtin_amdgcn_global_load_lds((const unsigned*)((const char*)(gbase) + (voff)[_i]), (LAS unsigned*)(lds + (bufoff) + ldsw + _i * 8192), 16, 0, 0); } while (0)
#define PG8_LDA(dst, b, h) do { _Pragma("unroll") for (int m = 0; m < 4; ++m) _Pragma("unroll") for (int k = 0; k < 2; ++k) dst[m][k] = *(const LAS bf16x8*)(lds + PG8_SA(b, h) + aoff + m * 2048 + k * 1024); } while (0)
#define PG8_LDB(dst, b, h) do { _Pragma("unroll") for (int n = 0; n < 2; ++n) _Pragma("unroll") for (int k = 0; k < 2; ++k) dst[n][k] = *(const LAS bf16x8*)(lds + PG8_SB(b, h) + boff + n * 2048 + k * 1024); } while (0)
#define PG8_MMA(ai, bj, At, Bt) do { __builtin_amdgcn_s_setprio(1); _Pragma("unroll") for (int m = 0; m < 4; ++m) _Pragma("unroll") for (int n = 0; n < 2; ++n) _Pragma("unroll") for (int k = 0; k < 2; ++k) \
        acc[ai][bj][m][n] = __builtin_amdgcn_mfma_f32_16x16x32_bf16(Bt[n][k], At[m][k], acc[ai][bj][m][n], 0, 0, 0); __builtin_amdgcn_s_setprio(0); } while (0)
#define PG8_WAIT_V(n) asm volatile("s_waitcnt vmcnt(" #n ")" ::: "memory")
#define PG8_WAIT_L(n) asm volatile("s_waitcnt lgkmcnt(" #n ")" ::: "memory")
#define PG8_BAR __builtin_amdgcn_s_barrier()
#define PG8_SCHED __builtin_amdgcn_sched_barrier(0)
    Unit cur, nxt; int ui = 0;
    if (!S.next(0, cur)) return;
    f32x4 acc[2][2][4][2];
#pragma unroll
    for (int a = 0; a < 2; ++a)
#pragma unroll
        for (int b = 0; b < 2; ++b)
#pragma unroll
            for (int m = 0; m < 4; ++m)
#pragma unroll
                for (int n = 0; n < 2; ++n) acc[a][b][m][n] = (f32x4){0.f, 0.f, 0.f, 0.f};
    bf16x8 At[4][2], B0[2][2], B1[2][2];
    const char* cA = (const char*)g.A + (size_t)cur.pm * tstep; const char* cB = (const char*)g.Bt + (size_t)cur.pn * tstep;
    PG8_STAGE(PG8_SB(0, 0), cB, voffB); PG8_STAGE(PG8_SB(0, 1), cB + hstep, voffB); PG8_STAGE(PG8_SA(0, 0), cA, voffA); PG8_STAGE(PG8_SA(0, 1), cA + hstep, voffA);
    if (wr == 1) PG8_BAR;
    PG8_WAIT_V(2); PG8_BAR;
    PG8_STAGE(PG8_SB(1, 0), cB + kstep, voffB); PG8_STAGE(PG8_SA(1, 0), cA + kstep, voffA); PG8_STAGE(PG8_SB(1, 1), cB + hstep + kstep, voffB);
    PG8_WAIT_V(6); PG8_BAR;
    for (;;) {
        const bool has_next = S.next(ui + 1, nxt);
        const char* nA = has_next ? (const char*)g.A + (size_t)nxt.pm * tstep : cA; const char* nB = has_next ? (const char*)g.Bt + (size_t)nxt.pn * tstep : cB;
        for (int t = 0; t < nt; t += 2) {
            const bool last = (t == nt - 2);
            const char* a1 = cA + (size_t)(t + 1) * kstep;
            const char* a2 = last ? nA : cA + (size_t)(t + 2) * kstep; const char* b2 = last ? nB : cB + (size_t)(t + 2) * kstep;
            const char* a3 = a2 + kstep; const char* b3 = b2 + kstep;
            PG8_LDB(B0, 0, 0); PG8_LDB(B1, 0, 1); PG8_SCHED; PG8_LDA(At, 0, 0); PG8_STAGE(PG8_SA(1, 1), a1 + hstep, voffA);
            PG8_WAIT_V(8); PG8_WAIT_L(0); PG8_BAR; PG8_MMA(0, 0, At, B0); PG8_MMA(0, 1, At, B1); PG8_BAR; PG8_SCHED;
            PG8_LDA(At, 0, 1); PG8_STAGE(PG8_SB(0, 0), b2, voffB); PG8_STAGE(PG8_SB(0, 1), b2 + hstep, voffB); PG8_STAGE(PG8_SA(0, 0), a2, voffA);
            PG8_WAIT_V(8); PG8_WAIT_L(0); PG8_BAR; PG8_MMA(1, 0, At, B0); PG8_MMA(1, 1, At, B1); PG8_BAR; PG8_SCHED;
            PG8_LDB(B0, 1, 0); PG8_LDB(B1, 1, 1); PG8_SCHED; PG8_LDA(At, 1, 0); PG8_STAGE(PG8_SA(0, 1), a2 + hstep, voffA);
            PG8_WAIT_V(8); PG8_WAIT_L(0); PG8_BAR; PG8_MMA(0, 0, At, B0); PG8_MMA(0, 1, At, B1); PG8_BAR; PG8_SCHED;
            PG8_LDA(At, 1, 1); PG8_STAGE(PG8_SB(1, 0), b3, voffB); PG8_STAGE(PG8_SB(1, 1), b3 + hstep, voffB); PG8_STAGE(PG8_SA(1, 0), a3, voffA);
            PG8_WAIT_V(8); PG8_WAIT_L(0); PG8_BAR; PG8_MMA(1, 0, At, B0); PG8_MMA(1, 1, At, B1); PG8_BAR; PG8_SCHED;
        }
        if constexpr (ALIGN_EPI) { if (wr == 0) PG8_BAR; }
        E(acc, cur, wr, wc, fr, fq);
        if (!has_next) break;
#pragma unroll
        for (int a = 0; a < 2; ++a)
#pragma unroll
            for (int b = 0; b < 2; ++b)
#pragma unroll
                for (int m = 0; m < 4; ++m)
#pragma unroll
                    for (int n = 0; n < 2; ++n) acc[a][b][m][n] = (f32x4){0.f, 0.f, 0.f, 0.f};
        cur = nxt; cA = nA; cB = nB; ++ui;
        if constexpr (ALIGN_EPI) { if (wr == 1) PG8_BAR; }
    }
    PG8_WAIT_V(0);
    if constexpr (!ALIGN_EPI) { if (wr == 0) PG8_BAR; }
    PG8_BAR;
#undef PG8_SA
#undef PG8_SB
#undef PG8_STAGE
#undef PG8_LDA
#undef PG8_LDB
#undef PG8_MMA
#undef PG8_WAIT_V
#undef PG8_WAIT_L
#undef PG8_BAR
#undef PG8_SCHED
}
}

namespace att {
constexpr int KROW = 144, KBUF = 64 * KROW;
constexpr int OFF_K = 0, OFF_V = 4 * KBUF, OFF_C = 8 * KBUF, OFF_LUT = OFF_C + SEQ * 4, LUT_N = 320, OFF_FLAG = OFF_LUT + LUT_N * 4;
constexpr int OFF_LUT_SWA = 12 * KBUF;
constexpr float DEAD = -136.f;
enum { M_SB = 0, M_SWA = 1, M_FOX = 2 };

__device__ __forceinline__ float other_half(float x, int hi) {
    const unsigned u = __float_as_uint(x); auto rr = __builtin_amdgcn_permlane32_swap(u, u, false, false);
    return __uint_as_float(hi ? rr[0] : rr[1]);
}
__device__ __forceinline__ f32x16 mfma32(bf16x8 a, bf16x8 b, f32x16 c) { return __builtin_amdgcn_mfma_f32_32x32x16_bf16(a, b, c, 0, 0, 0); }

__device__ __forceinline__ void pv_block(f32x16 (&o)[2], const f32x16& p, const LAS unsigned char* vb) {
#pragma unroll
    for (int j = 0; j < 2; ++j) {
        u32x4 pw; pw.x = cvt_pk(p[8 * j + 0], p[8 * j + 1]); pw.y = cvt_pk(p[8 * j + 2], p[8 * j + 3]); pw.z = cvt_pk(p[8 * j + 4], p[8 * j + 5]); pw.w = cvt_pk(p[8 * j + 6], p[8 * j + 7]);
        const bf16x8 pf = __builtin_bit_cast(bf16x8, pw);
#pragma unroll
        for (int db = 0; db < 2; ++db) { const bf16x8 vf = *(const LAS bf16x8*)(vb + db * 32 * KROW + j * 16); o[db] = mfma32(vf, pf, o[db]); }
    }
}
template <bool DIAG>
__device__ __forceinline__ void sb_block_t(f32x16& s, float& carry, int keybase, int tpos, int hi) {
    float tot = 0.f;
#pragma unroll
    for (int r = 15; r >= 0; --r) {
        const float z = s[r]; const float e = ex2(-z); const float L = lg2(1.f + e);
        const bool valid = !DIAG || (keybase + r < tpos);
        const float lsn = valid ? -(L + z) : 0.f;
        const float a = tot; tot += lsn; s[r] = valid ? (a - L) : -INFINITY;
    }
    const float other = other_half(tot, hi);
    const float base = carry + (hi ? 0.f : other);
#pragma unroll
    for (int r = 0; r < 16; ++r) s[r] = ex2(s[r] + base);
    carry += tot + other;
}
__device__ __forceinline__ void sb_block(f32x16& s, float& carry, int keybase, int tpos, bool diag, int hi) {
    if (diag) { asm volatile("" ::: "memory"); sb_block_t<true>(s, carry, keybase, tpos, hi); }
    else sb_block_t<false>(s, carry, keybase, tpos, hi);
}
__device__ __forceinline__ void sm_tile(f32x16& s0, f32x16& s1, f32x16 (&o)[2], float& m, float& l) {
    float t = fmaxf(s0[0], s1[0]);
#pragma unroll
    for (int r = 1; r < 16; ++r) t = fmaxf(t, fmaxf(s0[r], s1[r]));
    { const unsigned u = __float_as_uint(t); auto rr = __builtin_amdgcn_permlane32_swap(u, u, false, false); t = fmaxf(__uint_as_float(rr[0]), __uint_as_float(rr[1])); }
    const float mn = fmaxf(m, t); const float alpha = ex2(m - mn); m = mn; l *= alpha;
    if (__any(alpha != 1.f)) { o[0] *= alpha; o[1] *= alpha; }
    float sum = 0.f;
#pragma unroll
    for (int r = 0; r < 16; ++r) { s0[r] = ex2(s0[r] - mn); s1[r] = ex2(s1[r] - mn); sum += s0[r] + s1[r]; }
    l += sum;
}

template <int MODE>
__device__ __forceinline__ void attn_unit(LAS unsigned char* lds, const bf16_t* QKV, int ld, int qcol, int kcol, int vcol, bf16_t* OB, int ocol, int b, int qb, float sinkv, float kmax) {
    int tid = threadIdx.x; asm volatile("" : "+v"(tid));
    const int lane = tid & 63, w = __builtin_amdgcn_readfirstlane(tid >> 6), q32 = lane & 31, hi = lane >> 5;
    const int q0 = qb * 256, qw0 = q0 + 32 * w, tpos = qw0 + q32;
    const size_t rowb = (size_t)b * SEQ;
    bf16x8 qf[4];
    { const bf16_t* qp = QKV + (rowb + tpos) * ld + qcol + 8 * hi;
#pragma unroll
      for (int c = 0; c < 4; ++c) qf[c] = *(const bf16x8*)(qp + 16 * c); }
    const int skey = tid >> 3, sch = tid & 7;
    const bf16_t* kg = QKV + (rowb + skey) * ld + kcol + 8 * sch;
    const bf16_t* vg = QKV + (rowb + skey) * ld + vcol + 8 * sch;
    LAS unsigned char* Kb = lds + OFF_K; LAS unsigned char* Vb = lds + (MODE == M_SWA ? 6 * KBUF : OFF_V);
    const LAS float* carr = (const LAS float*)(lds + OFF_C); const LAS float* lut = (const LAS float*)(lds + OFF_LUT_SWA);
    const int kwr = skey * KROW + sch * 16, vwr = (8 * sch) * KROW + skey * 2;
    const int kperm = 16 * ((q32 >> 2) & 1) + 4 * (q32 >> 3) + (q32 & 3);
    const int krd = kperm * KROW + hi * 16, vrd = q32 * KROW + hi * 32;
    const int kt_hi = 4 * qb + 3, kt_lo = (MODE == M_SWA) ? (4 * qb - 2 > 0 ? 4 * qb - 2 : 0) : 0;

#define ATT_LOAD(KR, VR, t) do { KR = *(const u32x4*)(kg + (size_t)(t) * 64 * ld); VR = *(const u32x4*)(vg + (size_t)(t) * 64 * ld); } while (0)
    u32x4 kA, vA, kB, vB;
    if (MODE != M_SWA) { ATT_LOAD(kA, vA, kt_hi); ATT_LOAD(kB, vB, kt_hi - 1); }
    f32x16 o[2]; o[0] = (f32x16)(0.f); o[1] = (f32x16)(0.f);
    float carry = 0.f, m = (MODE == M_SWA) ? sinkv : -INFINITY, l = (MODE == M_SWA && hi == 0) ? 1.f : 0.f;
    float ct = 0.f, zb = 0.f;
    if (MODE == M_FOX) {
        float qq = 0.f;
#pragma unroll
        for (int c = 0; c < 4; ++c)
#pragma unroll
            for (int e = 0; e < 8; ++e) { const float x = __builtin_bit_cast(float, (unsigned)(unsigned short)qf[c][e] << 16); qq += x * x; }
        qq += __shfl_xor(qq, 32);
        zb = sqrtf(qq) * kmax * 1.002f + 0.01f; }
    volatile LAS unsigned* flag = (volatile LAS unsigned*)(lds + OFF_FLAG);
    if (MODE != M_SWA && tid == 0) { flag[0] = 0u; flag[1] = 0u; }
    bool wdead = false; unsigned dw0 = 0u, dw1 = 0u;

#define ATT_WRITE(buf, KR, VR) do { *(LAS u32x4*)(Kb + (buf) * KBUF + kwr) = KR; LAS unsigned short* vp_ = (LAS unsigned short*)(Vb + (buf) * KBUF + vwr); \
        vp_[0 * (KROW / 2)] = (unsigned short)(VR.x & 0xffffu); vp_[1 * (KROW / 2)] = (unsigned short)(VR.x >> 16); vp_[2 * (KROW / 2)] = (unsigned short)(VR.y & 0xffffu); vp_[3 * (KROW / 2)] = (unsigned short)(VR.y >> 16); \
        vp_[4 * (KROW / 2)] = (unsigned short)(VR.z & 0xffffu); vp_[5 * (KROW / 2)] = (unsigned short)(VR.z >> 16); vp_[6 * (KROW / 2)] = (unsigned short)(VR.w & 0xffffu); vp_[7 * (KROW / 2)] = (unsigned short)(VR.w >> 16); } while (0)
#define ATT_COMPUTE(kt_, cur_, par_) do { \
        const int k0 = (kt_) * 64; \
        bool active, diag; \
        if (MODE == M_SB) { active = k0 <= qw0 + 30; diag = k0 + 63 >= qw0; } \
        else if (MODE == M_FOX) { active = k0 <= qw0 + 31; diag = k0 + 63 > qw0; } \
        else { active = (k0 <= qw0 + 31) && (k0 + 63 >= qw0 - 127); diag = true; } \
        if (MODE == M_FOX && active && !wdead && !diag) { \
              \
            const float dmax = carr[k0 + 63];            \
            if (__all(dmax + zb - m <= DEAD)) { wdead = true; if (lane == 0) __hip_atomic_fetch_add((LAS unsigned*)(lds + OFF_FLAG) + (par_), 1u, __ATOMIC_RELAXED, __HIP_MEMORY_SCOPE_WORKGROUP); } \
        } \
        if (active && !wdead) { \
            const LAS unsigned char* kb_ = Kb + (cur_) * KBUF + krd; const LAS unsigned char* vb_ = Vb + (cur_) * KBUF + vrd; \
            f32x16 s0, s1; \
            if (MODE == M_FOX) { \
                  \
                const LAS f32x4* c0 = (const LAS f32x4*)(carr + k0 + 16 * hi); const LAS f32x4* c1 = (const LAS f32x4*)(carr + k0 + 32 + 16 * hi); \
                _Pragma("unroll") for (int i = 0; i < 4; ++i) { const f32x4 a = c0[i], bq = c1[i]; \
                    _Pragma("unroll") for (int j = 0; j < 4; ++j) { s0[4 * i + j] = a[j]; s1[4 * i + j] = bq[j]; } } \
            } else { s0 = (f32x16)(0.f); s1 = (f32x16)(0.f); } \
            _Pragma("unroll") for (int c = 0; c < 4; ++c) { \
                const bf16x8 k0f = *(const LAS bf16x8*)(kb_ + c * 32); const bf16x8 k1f = *(const LAS bf16x8*)(kb_ + 32 * KROW + c * 32); \
                s0 = mfma32(k0f, qf[c], s0); s1 = mfma32(k1f, qf[c], s1); } \
            const int kbase0 = k0 + 16 * hi, kbase1 = k0 + 32 + 16 * hi; \
            if (MODE == M_SB) { \
                sb_block(s1, carry, kbase1, tpos, diag, hi); \
                pv_block(o, s1, vb_ + 64); \
                sb_block(s0, carry, kbase0, tpos, diag, hi); \
                pv_block(o, s0, vb_); \
                  \
                if (__all(carry <= DEAD)) { wdead = true; if (lane == 0) __hip_atomic_fetch_add((LAS unsigned*)(lds + OFF_FLAG) + (par_), 1u, __ATOMIC_RELAXED, __HIP_MEMORY_SCOPE_WORKGROUP); } \
            } else { \
                if (MODE == M_SWA) { \
                    const LAS float* l0 = lut + (tpos - kbase0 + 64 - 15); const LAS float* l1 = lut + (tpos - kbase1 + 64 - 15); \
                    _Pragma("unroll") for (int r = 0; r < 16; ++r) { \
                        const int rel0 = tpos - (kbase0 + r), rel1 = tpos - (kbase1 + r); \
                        s0[r] = (rel0 >= 0 && rel0 < 128) ? s0[r] + l0[15 - r] : -INFINITY; \
                        s1[r] = (rel1 >= 0 && rel1 < 128) ? s1[r] + l1[15 - r] : -INFINITY; } \
                } else if (diag) { asm volatile("" ::: "memory");        \
                    _Pragma("unroll") for (int r = 0; r < 16; ++r) { if (kbase0 + r > tpos) s0[r] = -INFINITY; if (kbase1 + r > tpos) s1[r] = -INFINITY; } \
                } \
                sm_tile(s0, s1, o, m, l); \
                pv_block(o, s1, vb_ + 64); \
                pv_block(o, s0, vb_); \
            } \
        } } while (0)

#define ATT_COMPUTE2(kt_, sa_, sb_, par_) do { \
        const int k0a = (kt_) * 64, k0b = k0a - 64; \
        const bool diagA = (MODE == M_SB) ? (k0a + 63 >= qw0) : (k0a + 63 > qw0), diagB = (MODE == M_SB) ? (k0b + 63 >= qw0) : (k0b + 63 > qw0); \
        const bool fast = (MODE != M_SWA) && !wdead && (k0a <= qw0 + (MODE == M_SB ? 30 : 31));        \
        if (fast && MODE == M_FOX && !diagA) { \
            const float dmax = carr[k0a + 63]; \
            if (__all(dmax + zb - m <= DEAD)) { wdead = true; if (lane == 0) __hip_atomic_fetch_add((LAS unsigned*)(lds + OFF_FLAG) + (par_), 1u, __ATOMIC_RELAXED, __HIP_MEMORY_SCOPE_WORKGROUP); } \
        } \
        if (fast) { if (!wdead) { \
            const LAS unsigned char* kba = Kb + (sa_) * KBUF + krd; const LAS unsigned char* vba = Vb + (sa_) * KBUF + vrd; \
            const LAS unsigned char* kbb = Kb + (sb_) * KBUF + krd; const LAS unsigned char* vbb = Vb + (sb_) * KBUF + vrd; \
            f32x16 a0, a1, b0, b1; \
            if (MODE == M_FOX) { \
                const LAS f32x4* c0 = (const LAS f32x4*)(carr + k0a + 16 * hi); const LAS f32x4* c1 = (const LAS f32x4*)(carr + k0a + 32 + 16 * hi); \
                const LAS f32x4* d0 = (const LAS f32x4*)(carr + k0b + 16 * hi); const LAS f32x4* d1 = (const LAS f32x4*)(carr + k0b + 32 + 16 * hi); \
                _Pragma("unroll") for (int i = 0; i < 4; ++i) { const f32x4 x0 = c0[i], x1 = c1[i], y0 = d0[i], y1 = d1[i]; \
                    _Pragma("unroll") for (int j = 0; j < 4; ++j) { a0[4 * i + j] = x0[j]; a1[4 * i + j] = x1[j]; b0[4 * i + j] = y0[j]; b1[4 * i + j] = y1[j]; } } \
            } else { a0 = (f32x16)(0.f); a1 = (f32x16)(0.f); b0 = (f32x16)(0.f); b1 = (f32x16)(0.f); } \
            _Pragma("unroll") for (int c = 0; c < 4; ++c) { \
                const bf16x8 ka0 = *(const LAS bf16x8*)(kba + c * 32); const bf16x8 ka1 = *(const LAS bf16x8*)(kba + 32 * KROW + c * 32); \
                a0 = mfma32(ka0, qf[c], a0); a1 = mfma32(ka1, qf[c], a1); } \
            _Pragma("unroll") for (int c = 0; c < 4; ++c) { \
                const bf16x8 kb0 = *(const LAS bf16x8*)(kbb + c * 32); const bf16x8 kb1 = *(const LAS bf16x8*)(kbb + 32 * KROW + c * 32); \
                b0 = mfma32(kb0, qf[c], b0); b1 = mfma32(kb1, qf[c], b1); } \
            if (MODE == M_SB) { \
                sb_block(a1, carry, k0a + 32 + 16 * hi, tpos, diagA, hi); pv_block(o, a1, vba + 64); \
                sb_block(a0, carry, k0a + 16 * hi, tpos, diagA, hi); pv_block(o, a0, vba); \
                if (__all(carry <= DEAD)) { wdead = true; if (lane == 0) __hip_atomic_fetch_add((LAS unsigned*)(lds + OFF_FLAG) + (par_), 1u, __ATOMIC_RELAXED, __HIP_MEMORY_SCOPE_WORKGROUP); } \
                else { \
                    sb_block(b1, carry, k0b + 32 + 16 * hi, tpos, diagB, hi); pv_block(o, b1, vbb + 64); \
                    sb_block(b0, carry, k0b + 16 * hi, tpos, diagB, hi); pv_block(o, b0, vbb); \
                    if (__all(carry <= DEAD)) { wdead = true; if (lane == 0) __hip_atomic_fetch_add((LAS unsigned*)(lds + OFF_FLAG) + (par_), 1u, __ATOMIC_RELAXED, __HIP_MEMORY_SCOPE_WORKGROUP); } \
                } \
            } else { \
                if (diagA) { asm volatile("" ::: "memory"); const int ka0_ = k0a + 16 * hi, ka1_ = k0a + 32 + 16 * hi; \
                    _Pragma("unroll") for (int r = 0; r < 16; ++r) { if (ka0_ + r > tpos) a0[r] = -INFINITY; if (ka1_ + r > tpos) a1[r] = -INFINITY; } } \
                sm_tile(a0, a1, o, m, l); pv_block(o, a1, vba + 64); pv_block(o, a0, vba); \
                const float dmaxb = carr[k0b + 63]; \
                if (MODE == M_FOX && !diagB && __all(dmaxb + zb - m <= DEAD)) { wdead = true; if (lane == 0) __hip_atomic_fetch_add((LAS unsigned*)(lds + OFF_FLAG) + (par_), 1u, __ATOMIC_RELAXED, __HIP_MEMORY_SCOPE_WORKGROUP); } \
                else { \
                    if (diagB) { asm volatile("" ::: "memory"); const int kb0_ = k0b + 16 * hi, kb1_ = k0b + 32 + 16 * hi; \
                        _Pragma("unroll") for (int r = 0; r < 16; ++r) { if (kb0_ + r > tpos) b0[r] = -INFINITY; if (kb1_ + r > tpos) b1[r] = -INFINITY; } } \
                    sm_tile(b0, b1, o, m, l); pv_block(o, b1, vbb + 64); pv_block(o, b0, vbb); } \
            } \
        } } else { ATT_COMPUTE(kt_, sa_, par_); ATT_COMPUTE((kt_) - 1, sb_, par_); } \
    } while (0)

    if (MODE == M_SWA) {
        const int nt = kt_hi - kt_lo + 1;
        u32x4 kr[6], vr[6];
#pragma unroll
        for (int t = 0; t < 6; ++t) if (t < nt) ATT_LOAD(kr[t], vr[t], kt_lo + t);
#pragma unroll
        for (int t = 0; t < 6; ++t) if (t < nt) ATT_WRITE(t, kr[t], vr[t]);
        __syncthreads();
        for (int kt = kt_hi; kt >= kt_lo; --kt) { const int slot = kt - kt_lo; ATT_COMPUTE(kt, slot, 0); }
        __syncthreads();
    } else {
        ATT_WRITE(0, kA, vA); ATT_WRITE(1, kB, vB);
        ATT_LOAD(kA, vA, kt_hi - 2); ATT_LOAD(kB, vB, kt_hi - 3);
        __syncthreads();
        int kt = kt_hi;
        for (;;) {
            if (kt - 2 >= kt_lo) { ATT_WRITE(2, kA, vA); ATT_WRITE(3, kB, vB); if (kt - 4 >= kt_lo) { ATT_LOAD(kA, vA, kt - 4); ATT_LOAD(kB, vB, kt - 5); } }
            ATT_COMPUTE2(kt, 0, 1, 0);
            __syncthreads();
            dw0 = flag[0];
            if (dw0 + dw1 >= 8u) break;
            kt -= 2; if (kt < kt_lo) break;
            if (kt - 2 >= kt_lo) { ATT_WRITE(0, kA, vA); ATT_WRITE(1, kB, vB); if (kt - 4 >= kt_lo) { ATT_LOAD(kA, vA, kt - 4); ATT_LOAD(kB, vB, kt - 5); } }
            ATT_COMPUTE2(kt, 2, 3, 1);
            __syncthreads();
            dw1 = flag[1];
            if (dw0 + dw1 >= 8u) break;
            kt -= 2; if (kt < kt_lo) break;
        }
        __syncthreads();
    }
#undef ATT_LOAD
#undef ATT_WRITE
#undef ATT_COMPUTE
#undef ATT_COMPUTE2
    float inv = 1.f;
    if (MODE != M_SB) { const float lt = l + __shfl_xor(l, 32); inv = 1.f / lt; }
    {
        LAS unsigned char* stg = lds + w * (32 * KROW);
#pragma unroll
        for (int db = 0; db < 2; ++db)
#pragma unroll
            for (int a = 0; a < 4; ++a) { u32x2 wv; wv.x = cvt_pk(o[db][4 * a] * inv, o[db][4 * a + 1] * inv); wv.y = cvt_pk(o[db][4 * a + 2] * inv, o[db][4 * a + 3] * inv);
                *(LAS u32x2*)(stg + q32 * KROW + (32 * db + 8 * a + 4 * hi) * 2) = wv; }
        asm volatile("s_waitcnt lgkmcnt(0)" ::: "memory");
        bf16_t* ob = OB + (rowb + qw0) * D_MODEL + ocol;
#pragma unroll
        for (int i = 0; i < 4; ++i) { const int row = i * 8 + (lane >> 3), ch = lane & 7; const u32x4 v = *(const LAS u32x4*)(stg + row * KROW + ch * 16); *(u32x4*)(ob + (size_t)row * D_MODEL + ch * 8) = v; }
        __syncthreads();
    }
}

__device__ __forceinline__ int t5_bucket(int n) {
    if (n < 16) return n;
    int v = 16 + (int)(logf((float)n / 16.f) / 2.0794415416798357f * 16.f);
    return v < 31 ? v : 31;
}
}

constexpr size_t MiB = 1u << 20;
constexpr size_t WS_FFN_IN = 0, WS_FFN_OUT = 44 * MiB, WS_AB_IN = 66 * MiB, WS_AB_OUT = 70 * MiB + MiB / 2, WS_FOX_IN = 72 * MiB + MiB / 2, WS_FOX_OUT = 79 * MiB;
constexpr size_t WS_HB = 96 * MiB, WS_BIG = 160 * MiB, WS_OB = 352 * MiB, WS_F = 416 * MiB, WS_CTL = 419 * MiB, WS_XBUF = 420 * MiB, WS_LO = 421 * MiB, WS_END = 453 * MiB;
constexpr int CNT_OFF = 4096, CNT_WORDS = 6 * 128 * 64;
constexpr int LDS_X_OFF = 131072 + 1024;
constexpr int LDS_ST_OFF = 131072 + 320;
constexpr size_t FFN_IN_BYTES = 11 * MiB, FFN_OUT_BYTES = 5 * MiB + MiB / 2;
constexpr int LDS_BYTES = 147456;
constexpr int N_PHASES = 15;


#define XB_TMO      128
#define XB_XCNT(j)  (256  + 64 * (j))
#define XB_XSUB(j)  (1280 + 64 * (j))
#define XB_XGEN(j)  (2304 + 64 * (j))
#define XB_TOP      3328
#define XB_TOPGEN   3392
#define XCD_BAR_WORDS 3456
#define XB_SPIN_CAP (1u << 18)
__device__ __forceinline__ unsigned xb_ld(unsigned* p)              { return __hip_atomic_load(p, __ATOMIC_RELAXED, __HIP_MEMORY_SCOPE_AGENT); }
__device__ __forceinline__ unsigned xb_add(unsigned* p, unsigned v) { return __hip_atomic_fetch_add(p, v, __ATOMIC_RELAXED, __HIP_MEMORY_SCOPE_AGENT); }
__device__ __forceinline__ unsigned xb_xcc_id() { return (unsigned)__builtin_amdgcn_s_getreg((3 << 11) | 20) & 0xFu; }
#define XB_SPIN(cond, bar) do { unsigned _sp = 0; while (cond) { __builtin_amdgcn_s_sleep(1); \
    if ((++_sp & 255u) == 0u) { if (xb_ld(&(bar)[XB_TMO])) break; if (_sp > XB_SPIN_CAP) { atomicAdd(&(bar)[XB_TMO], 1u); break; } } } } while (0)
__device__ __forceinline__ void xcd_barrier_complete(unsigned* bar, unsigned x, unsigned& nloc, unsigned& nx) {
    const unsigned G = gridDim.x;
    unsigned sum, cnt, mine, sp = 0u;
    for (;;) {
        sum = 0u; cnt = 0u; mine = 0u;
#pragma unroll
        for (unsigned j = 0; j < 16; ++j) { const unsigned c = xb_ld(&bar[XB_XCNT(j)]); sum += c; cnt += (c > 0u) ? 1u : 0u; mine = (j == x) ? c : mine; }
        if (sum == G) break;
        __builtin_amdgcn_s_sleep(1);
        if ((++sp & 255u) == 0u) { if (xb_ld(&bar[XB_TMO])) break; if (sp > XB_SPIN_CAP) { atomicAdd(&bar[XB_TMO], 1u); break; } }
    }
    nloc = mine > 0u ? mine : 1u; nx = cnt > 0u ? cnt : 1u;
}
__device__ __forceinline__ void xcd_barrier(unsigned* bar, volatile LAS unsigned* st) {
    asm volatile("s_waitcnt vmcnt(0)" ::: "memory");
    __syncthreads();
    if (threadIdx.x == 0) {
        const unsigned x = xb_xcc_id();
        __builtin_amdgcn_s_waitcnt(0);
        unsigned nloc = st[0], nx = st[1];
        if (nloc == 0u) { xcd_barrier_complete(bar, x, nloc, nx); st[0] = nloc; st[1] = nx; }
        const unsigned old = xb_add(&bar[XB_XSUB(x)], 1u);
        const unsigned gen = old / nloc;
        if (old + 1u == (gen + 1u) * nloc) {
            __builtin_amdgcn_fence(__ATOMIC_RELEASE, "agent");
            asm volatile("s_waitcnt vmcnt(0)" ::: "memory");
            const unsigned og = xb_add(&bar[XB_TOP], 1u);
            const unsigned tg = og / nx;
            if (og + 1u == (tg + 1u) * nx) xb_add(&bar[XB_TOPGEN], 1u);
            else XB_SPIN(xb_ld(&bar[XB_TOPGEN]) == tg, bar);
            __builtin_amdgcn_fence(__ATOMIC_ACQUIRE, "agent");
            xb_add(&bar[XB_XGEN(x)], 1u);
            asm volatile("s_waitcnt vmcnt(0)" ::: "memory");
        } else {
            XB_SPIN(xb_ld(&bar[XB_XGEN(x)]) == gen, bar);
            __builtin_amdgcn_fence(__ATOMIC_ACQUIRE, "agent");
            asm volatile("s_waitcnt vmcnt(0)" ::: "memory");
        }
    }
    __syncthreads();
}

struct Args { const float* in[14]; float* out; unsigned char* ws; int ph_lo, ph_hi; };

__device__ __forceinline__ float wave_sum(float v) {
#pragma unroll
    for (int o = 1; o < 64; o <<= 1) v += __shfl_xor(v, o);
    return v;
}
__device__ __forceinline__ unsigned f2bf(float f) { unsigned u = __builtin_bit_cast(unsigned, f); return (u + 0x7fffu + ((u >> 16) & 1u)) >> 16; }
__device__ __forceinline__ unsigned pk2(float lo, float hi) { return f2bf(lo) | (f2bf(hi) << 16); }

__device__ __forceinline__ void transpose_item(const float* W, int ldw, int K, bf16_t* WT, int k0, int n0, int drow0, LAS float* scr, int lane) {
#pragma unroll
    for (int i = 0; i < 8; ++i) { const int idx = lane + 64 * i, kk = idx >> 3, c4 = idx & 7; const f32x4 v = *(const f32x4*)(W + (size_t)(k0 + kk) * ldw + n0 + 4 * c4);
        LAS float* d = scr + kk * 33 + 4 * c4; d[0] = v[0]; d[1] = v[1]; d[2] = v[2]; d[3] = v[3]; }
    asm volatile("s_waitcnt lgkmcnt(0)" ::: "memory");
    const int c = lane & 7;
#pragma unroll
    for (int j = 0; j < 4; ++j) { const int n = (lane >> 3) + 8 * j; const LAS float* s = scr + (8 * c) * 33 + n;
        u32x4 o; o.x = pk2(s[0 * 33], s[1 * 33]); o.y = pk2(s[2 * 33], s[3 * 33]); o.z = pk2(s[4 * 33], s[5 * 33]); o.w = pk2(s[6 * 33], s[7 * 33]);
        *(u32x4*)(WT + (size_t)(drow0 + n) * K + k0 + 8 * c) = o; }
    asm volatile("s_waitcnt lgkmcnt(0)" ::: "memory");
}

__global__ void __launch_bounds__(512, 2) mega(Args args) {
    extern __shared__ __attribute__((aligned(16))) unsigned char lds_raw[];
    LAS unsigned char* lds = (LAS unsigned char*)lds_raw;
    cg::grid_group grid = cg::this_grid();
    typedef const __attribute__((address_space(4))) Args* kargp_t;
    if (threadIdx.x < 2) ((volatile LAS unsigned*)(lds + LDS_ST_OFF))[threadIdx.x] = 0u;
    __syncthreads();

    for (int pp = args.ph_lo; pp < args.ph_hi; ++pp) {
        const int p = pp;
        int tid = threadIdx.x; asm volatile("" : "+v"(tid));
        int bid = blockIdx.x; asm volatile("" : "+s"(bid));
        int G = gridDim.x; asm volatile("" : "+s"(G));
        const int lane = tid & 63, wave = __builtin_amdgcn_readfirstlane(tid >> 6);
        const int gw = bid * 8 + wave, NGW = G * 8;
        kargp_t ap = (kargp_t)__builtin_amdgcn_kernarg_segment_ptr(); asm volatile("" : "+s"(ap));
        unsigned char* ws = ap->ws;
        bf16_t* HB = (bf16_t*)(ws + WS_HB); bf16_t* BIG = (bf16_t*)(ws + WS_BIG); bf16_t* OB = (bf16_t*)(ws + WS_OB); float* FB = (float*)(ws + WS_F);
        float* out = ap->out;
        if (EN_P0 && p == 0) {
            LAS float* scr = (LAS float*)(lds + wave * 16384);
            constexpr int I_IN = 16 * 176, I_OUT = 44 * 32, I_ABI = 16 * 72, I_O = 16 * 32, I_FXI = 16 * 96;
            constexpr int NITEMS = 4 * I_IN + 4 * I_OUT + I_ABI + I_O + I_FXI + I_O;
            for (int it = gw; it < NITEMS; it += NGW) {
                int r = it; const float* src; int ldw, K, nblk; bf16_t* dst; int mode = 0;
                if (r < 4 * I_IN) { const int idx = r / I_IN; r -= idx * I_IN; src = ap->in[(idx & 1) ? 5 : 3] + (size_t)(idx >> 1) * D_MODEL * 2 * D_FF; ldw = 2 * D_FF; K = D_MODEL; nblk = 176; dst = (bf16_t*)(ws + WS_FFN_IN + idx * FFN_IN_BYTES); mode = 1; }
                else if ((r -= 4 * I_IN) < 4 * I_OUT) { const int idx = r / I_OUT; r -= idx * I_OUT; src = ap->in[(idx & 1) ? 6 : 4] + (size_t)(idx >> 1) * D_FF * D_MODEL; ldw = D_MODEL; K = D_FF; nblk = 32; dst = (bf16_t*)(ws + WS_FFN_OUT + idx * FFN_OUT_BYTES); }
                else if ((r -= 4 * I_OUT) < I_ABI) { src = ap->in[7]; ldw = AB_IN; K = D_MODEL; nblk = 72; dst = (bf16_t*)(ws + WS_AB_IN); }
                else if ((r -= I_ABI) < I_O) { src = ap->in[8]; ldw = D_MODEL; K = D_MODEL; nblk = 32; dst = (bf16_t*)(ws + WS_AB_OUT); }
                else if ((r -= I_O) < I_FXI) { src = ap->in[10]; ldw = FOX_IN; K = D_MODEL; nblk = 96; dst = (bf16_t*)(ws + WS_FOX_IN); }
                else { r -= I_FXI; src = ap->in[12]; ldw = D_MODEL; K = D_MODEL; nblk = 32; dst = (bf16_t*)(ws + WS_FOX_OUT); }
                const int kb = r / nblk, nb = r - kb * nblk, n0 = 32 * nb;
                int drow0 = n0;
                if (mode == 1) { const int j = n0 < D_FF ? n0 : n0 - D_FF; drow0 = 256 * (j >> 7) + (j & 127) + (n0 < D_FF ? 0 : 128); }
                transpose_item(src, ldw, K, dst, 64 * kb, n0, drow0, scr, lane);
            }
            if (bid == 0) { unsigned* ctl = (unsigned*)(ws + WS_CTL); for (int i = tid; i < XCD_BAR_WORDS; i += 512) ctl[i] = 0u; }
            { unsigned* ctl = (unsigned*)(ws + WS_CTL) + CNT_OFF; for (int i = bid * 512 + tid; i < CNT_WORDS; i += G * 512) ctl[i] = 0u; }
            { bf16_t* dst = (bf16_t*)(ws + WS_FOX_IN); const float* src = ap->in[10];
              for (int i = bid * 512 + tid; i < 16 * D_MODEL; i += G * 512) { const int n = i >> 10, k = i & 1023; dst[(size_t)(FOX_QKV + n) * D_MODEL + k] = (bf16_t)f2bf(src[(size_t)k * FOX_IN + FOX_QKV + n]); } }
            for (int mrow = gw; mrow < MTOK; mrow += NGW) {
                const float* xr = ap->in[0] + (size_t)mrow * D_MODEL; bf16_t* hr = HB + (size_t)mrow * D_MODEL; unsigned char* lr = ws + WS_LO + (size_t)mrow * D_MODEL;
#pragma unroll
                for (int j = 0; j < 2; ++j) { const int c8 = 8 * (lane + 64 * j); u32x4 wv; u32x2 qv;
#pragma unroll
                    for (int n = 0; n < 2; ++n) { const f32x4 v = *(const f32x4*)(xr + c8 + 4 * n); const unsigned w0 = cvt_pk(v[0], v[1]), w1 = cvt_pk(v[2], v[3]);
                        const float l0 = (v[0] - __builtin_bit_cast(float, w0 << 16)) * 4096.f + 128.5f, l1 = (v[1] - __builtin_bit_cast(float, w0 & 0xffff0000u)) * 4096.f + 128.5f;
                        const float l2 = (v[2] - __builtin_bit_cast(float, w1 << 16)) * 4096.f + 128.5f, l3 = (v[3] - __builtin_bit_cast(float, w1 & 0xffff0000u)) * 4096.f + 128.5f;
                        const unsigned q = (unsigned)(int)fminf(fmaxf(l0, 0.f), 255.f) | ((unsigned)(int)fminf(fmaxf(l1, 0.f), 255.f) << 8) | ((unsigned)(int)fminf(fmaxf(l2, 0.f), 255.f) << 16) | ((unsigned)(int)fminf(fmaxf(l3, 0.f), 255.f) << 24);
                        if (n == 0) { wv.x = w0; wv.y = w1; qv.x = q; } else { wv.z = w0; wv.w = w1; qv.y = q; } }
                    *(u32x4*)(hr + c8) = wv; *(u32x2*)(lr + c8) = qv; }
            }
        } else {
            const int L = (p - 1) / 7, s = (p - 1) % 7;
            if (EN_G1 && (s == 0 || s == 5)) {
                const int idx = L * 2 + (s == 5 ? 1 : 0);
                pg8::Gemm g{HB, (const bf16_t*)(ws + WS_FFN_IN + idx * FFN_IN_BYTES), MTOK, 2 * D_FF, D_MODEL};
                pg8::StaticOrder S; S.init(MTOK, 2 * D_FF, G, bid, WGM_FFN_IN);
                pg8::EpiSwiGLU E{BIG, D_FF};
                pg8::gemm_phase<pg8::EpiSwiGLU, pg8::StaticOrder>(lds, g, S, E);
            } else if (EN_G2 && (s == 1 || s == 4 || s == 6)) {
                const bf16_t* A; const bf16_t* Bt; int K; float cs;
                const int li = L * 3 + (s == 1 ? 0 : (s == 4 ? 1 : 2));
                if (s == 4) { A = OB; Bt = (const bf16_t*)(ws + (L == 0 ? WS_AB_OUT : WS_FOX_OUT)); K = D_MODEL; cs = 1.f; }
                else { const int idx = L * 2 + (s == 6 ? 1 : 0); A = BIG; Bt = (const bf16_t*)(ws + WS_FFN_OUT + idx * FFN_OUT_BYTES); K = D_FF; cs = 0.5f; }
                pg8::Gemm g{A, Bt, MTOK, D_MODEL, K};
                pg8::StaticOrder S; S.init(MTOK, D_MODEL, G, bid, WGM_OUT);
                pg8::EpiLnFused E{(L == 1 && s == 6) ? out : (float*)nullptr, HB, ws + WS_LO, ALPHA, cs, ap->in[1] + (size_t)li * D_MODEL, ap->in[2] + (size_t)li * D_MODEL,
                                  (unsigned long long*)(ws + WS_XBUF), (unsigned*)(ws + WS_CTL) + CNT_OFF + li * 128 * 64, lds + LDS_X_OFF};
                pg8::gemm_phase<pg8::EpiLnFused, pg8::StaticOrder>(lds, g, S, E);
            } else if (EN_G3 && s == 2) {
                const bool ab = (L == 0);
                if (!ab) {
                    const bf16_t* wf = (const bf16_t*)(ws + WS_FOX_IN) + (size_t)FOX_QKV * D_MODEL;
                    for (int task = gw; task < MTOK / 16; task += NGW) {
                        const bf16_t* ap_ = HB + (size_t)(task * 16 + (lane & 15)) * D_MODEL + 8 * (lane >> 4); const bf16_t* bp_ = wf + (size_t)(lane & 15) * D_MODEL + 8 * (lane >> 4);
                        f32x4 fa = (f32x4){0.f, 0.f, 0.f, 0.f};
#pragma unroll 8
                        for (int k = 0; k < D_MODEL; k += 32) fa = __builtin_amdgcn_mfma_f32_16x16x32_bf16(*(const bf16x8*)(ap_ + k), *(const bf16x8*)(bp_ + k), fa, 0, 0, 0);
                        *(f32x4*)(FB + (size_t)(lane & 15) * MTOK + task * 16 + 4 * (lane >> 4)) = fa;
                    }
                }
                pg8::Gemm g{HB, (const bf16_t*)(ws + (ab ? WS_AB_IN : WS_FOX_IN)), MTOK, ab ? AB_IN : FOX_QKV, D_MODEL};
                pg8::StaticOrder S; S.init(MTOK, g.N, G, bid, WGM_QKV);
                pg8::EpiQKV E{BIG, ab ? AB_IN : FOX_QKV, ab ? 0xC3u : 0xFu, FB, -1};
                pg8::gemm_phase<pg8::EpiQKV, pg8::StaticOrder>(lds, g, S, E);
            } else if (s == 3) {
                if (L == 0) {
                    for (int job = bid; job < 256; job += G) {
                        if (EN_SB) { const int bh = job >> 1, which = job & 1, b = bh >> 3, h = bh & 7;
                          for (int i = 0; i < 4; ++i) { const int qb = which ? (i == 0 ? 6 : i == 1 ? 5 : i == 2 ? 2 : 1) : (i == 0 ? 7 : i == 1 ? 4 : i == 2 ? 3 : 0);
                              att::attn_unit<att::M_SB>(lds, BIG, AB_IN, h * 64, 512 + h * 64, 1024 + h * 64, OB, h * 64, b, qb, 0.f, 0.f); } }
                        if (EN_SWA) for (int i = 0; i < 4; ++i) { const int idx = job * 4 + i, qb = idx & 7, hq = (idx >> 3) & 7, b = idx >> 6;
                            LAS float* lut = (LAS float*)(lds + att::OFF_LUT_SWA);
                            if (tid < att::LUT_N) { const int rel = tid - 64; lut[tid] = (rel >= 0 && rel < 128) ? ap->in[13][att::t5_bucket(rel) * 8 + hq] * LOG2E : 0.f; }
                            const float sinkv = ap->in[9][hq] * LOG2E;
                            att::attn_unit<att::M_SWA>(lds, BIG, AB_IN, 1536 + hq * 64, 2048 + (hq >> 2) * 64, 2176 + (hq >> 2) * 64, OB, 512 + hq * 64, b, qb, sinkv, 0.f); }
                    }
                } else {
                    if (EN_FOX) for (int job = bid; job < 256; job += G) {
                        const int b = job >> 4, h = job & 15;
                        LAS float* carr = (LAS float*)(lds + att::OFF_C); LAS float* wsum = (LAS float*)(lds + att::OFF_LUT);
                        const float bfh = ap->in[11][h];
                        float v[4]; const f32x4 fv = *(const f32x4*)(FB + (size_t)h * MTOK + (size_t)b * SEQ + tid * 4);
#pragma unroll
                        for (int i = 0; i < 4; ++i) { const float f = fv[i] + bfh; v[i] = (fminf(f, 0.f) - log1pf(expf(-fabsf(f)))) * LOG2E; }
                        v[1] += v[0]; v[2] += v[1]; v[3] += v[2];
                        float x = v[3];
#pragma unroll
                        for (int o = 1; o < 64; o <<= 1) { const float y = __shfl_up(x, o); if (lane >= o) x += y; }
                        float excl = __shfl_up(x, 1); if (lane == 0) excl = 0.f;
                        float kn = 0.f;
                        for (int i = 0; i < 4; ++i) { const u32x4* kp = (const u32x4*)(BIG + ((size_t)b * SEQ + tid * 4 + i) * FOX_QKV + 1024 + h * 64); float ss = 0.f;
#pragma unroll
                            for (int c = 0; c < 8; ++c) { const u32x4 kv = kp[c];
#pragma unroll
                                for (int e = 0; e < 4; ++e) { const float lo = __builtin_bit_cast(float, kv[e] << 16), hi2 = __builtin_bit_cast(float, kv[e] & 0xffff0000u); ss += lo * lo + hi2 * hi2; } }
                            kn = fmaxf(kn, ss); }
#pragma unroll
                        for (int o = 1; o < 64; o <<= 1) kn = fmaxf(kn, __shfl_xor(kn, o));
                        if (lane == 63) { wsum[wave] = x; wsum[8 + wave] = kn; }
                        __syncthreads();
                        float woff = 0.f, kmax = 0.f;
                        for (int i = 0; i < wave; ++i) woff += wsum[i];
                        for (int i = 0; i < 8; ++i) kmax = fmaxf(kmax, wsum[8 + i]);
                        kmax = sqrtf(kmax);
#pragma unroll
                        for (int i = 0; i < 4; ++i) carr[tid * 4 + i] = -(v[i] + excl + woff);
                        __syncthreads();
                        for (int qb = 7; qb >= 0; --qb)
                            att::attn_unit<att::M_FOX>(lds, BIG, FOX_QKV, h * 64, 1024 + h * 64, 2048 + h * 64, OB, h * 64, b, qb, 0.f, kmax);
                        __syncthreads();
                    }
                }
            }
        }
        if (pp + 1 < args.ph_hi) {
            if (pp == 0) { grid.sync();
                if (threadIdx.x == 0) (void)xb_add((unsigned*)(ap->ws + WS_CTL) + XB_XCNT(xb_xcc_id()), 1u); }
            else xcd_barrier((unsigned*)(ap->ws + WS_CTL), (volatile LAS unsigned*)(lds + LDS_ST_OFF));
        }
    }
}

extern "C" void kernel_launch(void* const* d_in, const int* in_sizes, int n_in, void* d_out, int out_size, void* d_ws, size_t ws_size, hipStream_t stream) {
    static int grid = 0;
    if (grid == 0) {
        if (n_in != 14 || out_size != MTOK * D_MODEL || ws_size < WS_END) { fprintf(stderr, "kernel_launch: unexpected problem (n_in %d, out %d, ws %zu)\n", n_in, out_size, ws_size); grid = -1; return; }
        int dev = 0, cus = 0, per_cu = 0;
        hipGetDevice(&dev); hipDeviceGetAttribute(&cus, hipDeviceAttributeMultiprocessorCount, dev);
        if (hipFuncSetAttribute((const void*)mega, hipFuncAttributeMaxDynamicSharedMemorySize, LDS_BYTES) != hipSuccess) { fprintf(stderr, "kernel_launch: hipFuncSetAttribute failed\n"); grid = -1; return; }
        if (hipOccupancyMaxActiveBlocksPerMultiprocessor(&per_cu, (const void*)mega, 512, LDS_BYTES) != hipSuccess || per_cu < 1) per_cu = 1;
        (void)hipGetLastError();
        grid = cus * per_cu;
        if (grid > 256) grid = 256;
        if (grid != 256) { fprintf(stderr, "kernel_launch: the fused LayerNorm epilogues need exactly 256 resident workgroups (got %d); nothing launched\n", grid); grid = -1; return; }
    }
    if (grid < 0) return;
    Args a{};
    for (int i = 0; i < 14; ++i) a.in[i] = (const float*)d_in[i];
    a.out = (float*)d_out; a.ws = (unsigned char*)d_ws;
#if MK_N_LAUNCHES == 1
    a.ph_lo = 0; a.ph_hi = N_PHASES;
    void* kargs[] = {&a};
    hipError_t e = hipLaunchCooperativeKernel((const void*)mega, dim3(grid), dim3(512), kargs, LDS_BYTES, stream);
    if (e != hipSuccess) fprintf(stderr, "cooperative launch failed: %s (grid %d)\n", hipGetErrorString(e), grid);
#else
    for (int p = 0; p < N_PHASES; ++p) { a.ph_lo = p; a.ph_hi = p + 1; hipLaunchKernelGGL(mega, dim3(grid), dim3(512), LDS_BYTES, stream, a); }
#endif
}
```

```cpp
#include <hip/hip_runtime.h>
#include <hip/hip_cooperative_groups.h>
#include <cstdint>
#include <cstdio>
#include <cmath>
namespace cg = cooperative_groups;

#ifndef MK_N_LAUNCHES
#define MK_N_LAUNCHES 1
#endif

#ifndef EN_P0
#define EN_P0 1
#endif
#ifndef EN_G1
#define EN_G1 1
#endif
#ifndef EN_G2
#define EN_G2 1
#endif
#ifndef EN_LN
#define EN_LN 1
#endif
#ifndef EN_G3
#define EN_G3 1
#endif
#ifndef EN_SB
#define EN_SB 1
#endif
#ifndef EN_SWA
#define EN_SWA 1
#endif
#ifndef EN_FOX
#define EN_FOX 1
#endif
#ifndef WGM_FFN_IN
#define WGM_FFN_IN 4
#endif
#ifndef WGM_OUT
#define WGM_OUT 4
#endif
#ifndef WGM_QKV
#define WGM_QKV 4
#endif
#define LAS __attribute__((address_space(3)))
typedef unsigned short bf16_t;
typedef short bf16x8 __attribute__((ext_vector_type(8)));
typedef float f32x2 __attribute__((ext_vector_type(2)));
typedef float f32x4 __attribute__((ext_vector_type(4)));
typedef float f32x16 __attribute__((ext_vector_type(16)));
typedef unsigned u32x2 __attribute__((ext_vector_type(2)));
typedef unsigned u32x4 __attribute__((ext_vector_type(4)));
typedef __bf16 bf16x2_t __attribute__((ext_vector_type(2)));

constexpr int D_MODEL = 1024, BATCH = 16, SEQ = 2048, MTOK = BATCH * SEQ, D_FF = 2816;
constexpr int AB_IN = 2304, FOX_QKV = 3072, FOX_IN = 3088, FOX_NPAD = 3328;
constexpr float LOG2E = 1.4426950408889634f;
constexpr float QSCALE = 0.125f * LOG2E;
constexpr float ALPHA = 1.4142135623730951f;
constexpr float LN_EPS = 1e-5f;

__device__ __forceinline__ unsigned cvt_pk(float lo, float hi) { f32x2 v = {lo, hi}; bf16x2_t b = __builtin_convertvector(v, bf16x2_t); return __builtin_bit_cast(unsigned, b); }
__device__ __forceinline__ float ex2(float x) { return __builtin_amdgcn_exp2f(x); }
__device__ __forceinline__ float lg2(float x) { return __builtin_amdgcn_logf(x); }

namespace pg8 {
constexpr int BM = 256, BK = 64, HALF = 128, HTB = HALF * BK * 2, STAGE_BYTES = 8 * HTB, NXCD = 8;
__host__ __device__ __forceinline__ int lds_byte(int r, int c) { const int st = (r >> 4) * 2 + (c >> 5), rr = r & 15, cc = c & 31, ob = rr * 64 + cc * 2; return st * 1024 + (ob ^ (((ob >> 9) & 1) << 5)); }
__host__ __device__ __forceinline__ void stage_rc(int b, int& R, int& C) { const int st = b / 1024, sb = b % 1024, swz = sb ^ (((sb >> 9) & 1) << 5); R = (st >> 1) * 16 + swz / 64; C = (st & 1) * 32 + (swz % 64) / 2; }
__host__ __device__ __forceinline__ int perm32(int rho) { const int n = rho >> 4, i = rho & 15; return 8 * (i >> 2) + 4 * n + (i & 3); }

struct Unit { int pm, pn; };
struct Gemm { const bf16_t* A; const bf16_t* Bt; int M, N, K; };

struct StaticOrder {
    int nM, nN, nwg, G, c, WGM;
    __host__ __device__ void init(int M, int N, int G_, int c_, int wgm_) { nM = M / BM; nN = N / BM; nwg = nM * nN; G = G_; c = c_; WGM = wgm_; }
    __host__ __device__ bool next(int i, Unit& u) const {
        const long L = (long)i * G + c; if (L >= nwg) return false;
        int wgid = (int)L; { const int q = nwg / NXCD, r = nwg % NXCD, xcd = wgid % NXCD, off = wgid / NXCD; wgid = (xcd < r ? xcd * (q + 1) : r * (q + 1) + (xcd - r) * q) + off; }
        const int nig = WGM * nN, gid = wgid / nig, fm = gid * WGM, gsz = (nM - fm) < WGM ? (nM - fm) : WGM;
        u.pm = fm + ((wgid % nig) % gsz); u.pn = (wgid % nig) / gsz; return true;
    }
};

struct EpiSwiGLU {
    static constexpr bool PERM = true;
    bf16_t* O; int ldc;
    __device__ __forceinline__ void operator()(const f32x4 (&acc)[2][2][4][2], const Unit& u, int wr, int wc, int fr, int fq) const {
        const int row0 = u.pm * BM + wr * 64 + fr; const int col0 = u.pn * HALF + wc * 32 + 8 * fq;
#pragma unroll
        for (int ai = 0; ai < 2; ++ai)
#pragma unroll
            for (int m = 0; m < 4; ++m) {
                bf16_t* rowp = O + (size_t)(row0 + ai * HALF + m * 16) * ldc + col0;
                float v[8];
#pragma unroll
                for (int n = 0; n < 2; ++n)
#pragma unroll
                    for (int j = 0; j < 4; ++j) { const float g = acc[ai][0][m][n][j], up = acc[ai][1][m][n][j];
                        v[n * 4 + j] = g * __builtin_amdgcn_rcpf(1.f + ex2(-LOG2E * g)) * up; }
                u32x4 w; w.x = cvt_pk(v[0], v[1]); w.y = cvt_pk(v[2], v[3]); w.z = cvt_pk(v[4], v[5]); w.w = cvt_pk(v[6], v[7]);
                *(u32x4*)rowp = w;
            }
    }
};
struct EpiQKV {
    static constexpr bool PERM = true;
    bf16_t* O; int ldc; unsigned qmask; float* F; int ftile;
    __device__ __forceinline__ void operator()(const f32x4 (&acc)[2][2][4][2], const Unit& u, int wr, int wc, int fr, int fq) const {
        const int row0 = u.pm * BM + wr * 64 + fr;
        if (u.pn == ftile) {
            if (wc == 0 && fq < 2) {
#pragma unroll
                for (int ai = 0; ai < 2; ++ai)
#pragma unroll
                    for (int m = 0; m < 4; ++m) { float* fp = F + (size_t)(row0 + ai * HALF + m * 16) * 16 + 8 * fq; *(f32x4*)fp = acc[ai][0][m][0]; *(f32x4*)(fp + 4) = acc[ai][0][m][1]; }
            }
            return;
        }
        const float sc = ((qmask >> u.pn) & 1u) ? QSCALE : 1.f;
        const int col0 = u.pn * BM + wc * 32 + 8 * fq;
#pragma unroll
        for (int ai = 0; ai < 2; ++ai)
#pragma unroll
            for (int m = 0; m < 4; ++m) { bf16_t* rowp = O + (size_t)(row0 + ai * HALF + m * 16) * ldc + col0;
#pragma unroll
                for (int bj = 0; bj < 2; ++bj) { const f32x4 v0 = acc[ai][bj][m][0] * sc, v1 = acc[ai][bj][m][1] * sc;
                    u32x4 w; w.x = cvt_pk(v0[0], v0[1]); w.y = cvt_pk(v0[2], v0[3]); w.z = cvt_pk(v1[0], v1[1]); w.w = cvt_pk(v1[2], v1[3]);
                    *(u32x4*)(rowp + bj * HALF) = w; } }
    }
};
struct EpiLnFused {
    static constexpr bool PERM = true;
    float* out32; bf16_t* hb; unsigned char* lob; float alpha, cs; const float* g; const float* b;
    unsigned long long* xbuf; unsigned* cnt; LAS unsigned char* xl;
    __device__ __forceinline__ void operator()(f32x4 (&acc)[2][2][4][2], const Unit& u, int wr, int wc, int fr, int fq) const {
        const int col0 = u.pn * BM + wc * 32 + 8 * fq; const int lo0 = u.pn * BM + wc * 64 + fq * 16;
        const int wid = wr * 4 + wc, lane = fq * 16 + fr, tid = wid * 64 + lane;
        LAS f32x2* P = (LAS f32x2*)xl; LAS f32x2* S = (LAS f32x2*)(xl + 8192); volatile LAS unsigned* flag = (volatile LAS unsigned*)(xl + 8192 + 2048);
        {
        const bf16_t* hbp = hb; const unsigned char* lobp = lob;
#pragma unroll
        for (int ai = 0; ai < 2; ++ai) {
            u32x4 hv[4][2]; u32x4 lv[4];
#pragma unroll
            for (int m = 0; m < 4; ++m) { const size_t rowo = (size_t)(u.pm * BM + ai * HALF + wr * 64 + m * 16 + fr) * D_MODEL; const size_t off = rowo + col0;
                lv[m] = *(const u32x4*)(lobp + rowo + lo0);
#pragma unroll
                for (int bj = 0; bj < 2; ++bj) hv[m][bj] = *(const u32x4*)(hbp + off + bj * HALF); }
#pragma unroll
            for (int m = 0; m < 4; ++m) {
#pragma unroll
                for (int bj = 0; bj < 2; ++bj)
#pragma unroll
                    for (int n = 0; n < 2; ++n) { const unsigned h0 = n ? hv[m][bj].z : hv[m][bj].x, h1 = n ? hv[m][bj].w : hv[m][bj].y; const unsigned lw = bj ? (n ? lv[m].w : lv[m].z) : (n ? lv[m].y : lv[m].x); f32x4 r;
                        r[0] = __builtin_bit_cast(float, h0 << 16) - 0.03125f + (float)(lw & 0xffu) * 0.000244140625f;
                        r[1] = __builtin_bit_cast(float, h0 & 0xffff0000u) - 0.03125f + (float)((lw >> 8) & 0xffu) * 0.000244140625f;
                        r[2] = __builtin_bit_cast(float, h1 << 16) - 0.03125f + (float)((lw >> 16) & 0xffu) * 0.000244140625f;
                        r[3] = __builtin_bit_cast(float, h1 & 0xffff0000u) - 0.03125f + (float)(lw >> 24) * 0.000244140625f;
                        acc[ai][bj][m][n] = r * alpha + acc[ai][bj][m][n] * cs; }
                asm volatile("" : "+v"(acc[ai][0][m][0]), "+v"(acc[ai][0][m][1]), "+v"(acc[ai][1][m][0]), "+v"(acc[ai][1][m][1])); }
            asm volatile("" : "+s"(hbp), "+s"(lobp) : "v"(acc[ai][1][3][1][3]) : "memory");
        }
        }
#pragma unroll
        for (int ai = 0; ai < 2; ++ai)
#pragma unroll
            for (int m = 0; m < 4; ++m) {
                float s1 = 0.f, s2 = 0.f;
#pragma unroll
                for (int bj = 0; bj < 2; ++bj)
#pragma unroll
                    for (int n = 0; n < 2; ++n) { const f32x4 x = acc[ai][bj][m][n]; s1 += (x[0] + x[1]) + (x[2] + x[3]); s2 += (x[0] * x[0] + x[1] * x[1]) + (x[2] * x[2] + x[3] * x[3]); }
                s1 += __shfl_xor(s1, 16); s1 += __shfl_xor(s1, 32); s2 += __shfl_xor(s2, 16); s2 += __shfl_xor(s2, 32);
                if (fq == 0) P[(ai * HALF + wr * 64 + m * 16 + fr) * 4 + wc] = (f32x2){s1, s2};
                __builtin_amdgcn_sched_barrier(0);
            }
        asm volatile("s_waitcnt lgkmcnt(0)" ::: "memory"); __builtin_amdgcn_s_barrier(); asm volatile("" ::: "memory");
        unsigned* pc = cnt + 64 * u.pm;
        if (tid < 256) { const f32x2 a = P[tid * 4 + 0], bq = P[tid * 4 + 1], c = P[tid * 4 + 2], d = P[tid * 4 + 3];
            const float t1 = (a.x + bq.x) + (c.x + d.x), t2 = (a.y + bq.y) + (c.y + d.y);
            __hip_atomic_store(xbuf + ((size_t)(u.pm * BM + tid) * 4 + u.pn), ((unsigned long long)__float_as_uint(t2) << 32) | __float_as_uint(t1), __ATOMIC_RELAXED, __HIP_MEMORY_SCOPE_AGENT); }
        asm volatile("s_waitcnt vmcnt(0)" ::: "memory");
        if (wid < 4 && lane == 0) __hip_atomic_fetch_add(pc, 1u, __ATOMIC_RELAXED, __HIP_MEMORY_SCOPE_AGENT);
        if (wid == 0) {
            for (unsigned sp = 0; sp < (1u << 20); ++sp) {
                if ((unsigned)__builtin_amdgcn_readfirstlane(__hip_atomic_load(pc, __ATOMIC_RELAXED, __HIP_MEMORY_SCOPE_AGENT)) >= 16u) break;
                __builtin_amdgcn_s_sleep(2);
            }
            __builtin_amdgcn_fence(__ATOMIC_ACQUIRE, "agent");
            if (lane == 0) flag[0] = 1u;
        }
        asm volatile("s_waitcnt vmcnt(0) lgkmcnt(0)" ::: "memory"); __builtin_amdgcn_s_barrier(); asm volatile("" ::: "memory");
        if (tid < 256) { const unsigned long long* slot = xbuf + (size_t)(u.pm * BM + tid) * 4; float t1 = 0.f, t2 = 0.f;
#pragma unroll
            for (int t = 0; t < 4; ++t) { const unsigned long long w = __hip_atomic_load(slot + t, __ATOMIC_RELAXED, __HIP_MEMORY_SCOPE_AGENT); t1 += __uint_as_float((unsigned)w); t2 += __uint_as_float((unsigned)(w >> 32)); }
            const float mean = t1 * (1.f / D_MODEL); const float var = fmaxf(t2 * (1.f / D_MODEL) - mean * mean, 0.f);
            S[tid] = (f32x2){mean, 1.f / sqrtf(var + LN_EPS)}; }
        asm volatile("s_waitcnt lgkmcnt(0)" ::: "memory"); __builtin_amdgcn_s_barrier(); asm volatile("" ::: "memory");
        f32x4 gv[2][2], bv[2][2];
#pragma unroll
        for (int bj = 0; bj < 2; ++bj)
#pragma unroll
            for (int n = 0; n < 2; ++n) { gv[bj][n] = *(const f32x4*)(g + col0 + bj * HALF + n * 4); bv[bj][n] = *(const f32x4*)(b + col0 + bj * HALF + n * 4); }
        if (out32) {
#pragma unroll
        for (int ai = 0; ai < 2; ++ai)
#pragma unroll
            for (int m = 0; m < 4; ++m) { const int rt = ai * HALF + wr * 64 + m * 16 + fr; const f32x2 st = S[rt]; const size_t off = (size_t)(u.pm * BM + rt) * D_MODEL + col0;
#pragma unroll
                for (int bj = 0; bj < 2; ++bj)
#pragma unroll
                    for (int n = 0; n < 2; ++n) *(f32x4*)(out32 + off + bj * HALF + n * 4) = (acc[ai][bj][m][n] - st.x) * st.y * gv[bj][n] + bv[bj][n];
                __builtin_amdgcn_sched_barrier(0); }
        } else {
#pragma unroll
        for (int ai = 0; ai < 2; ++ai)
#pragma unroll
            for (int m = 0; m < 4; ++m) { const int rt = ai * HALF + wr * 64 + m * 16 + fr; const f32x2 st = S[rt]; const size_t off = (size_t)(u.pm * BM + rt) * D_MODEL + col0;
                u32x4 qv;
#pragma unroll
                for (int bj = 0; bj < 2; ++bj) { u32x4 wv;
#pragma unroll
                    for (int n = 0; n < 2; ++n) { const f32x4 y = (acc[ai][bj][m][n] - st.x) * st.y * gv[bj][n] + bv[bj][n];
                        const unsigned w0 = cvt_pk(y[0], y[1]), w1 = cvt_pk(y[2], y[3]);
                        const float l0 = (y[0] - __builtin_bit_cast(float, w0 << 16)) * 4096.f + 128.5f, l1 = (y[1] - __builtin_bit_cast(float, w0 & 0xffff0000u)) * 4096.f + 128.5f;
                        const float l2 = (y[2] - __builtin_bit_cast(float, w1 << 16)) * 4096.f + 128.5f, l3 = (y[3] - __builtin_bit_cast(float, w1 & 0xffff0000u)) * 4096.f + 128.5f;
                        const unsigned q = (unsigned)(int)fminf(fmaxf(l0, 0.f), 255.f) | ((unsigned)(int)fminf(fmaxf(l1, 0.f), 255.f) << 8) | ((unsigned)(int)fminf(fmaxf(l2, 0.f), 255.f) << 16) | ((unsigned)(int)fminf(fmaxf(l3, 0.f), 255.f) << 24);
                        if (n == 0) { wv.x = w0; wv.y = w1; } else { wv.z = w0; wv.w = w1; }
                        if (bj == 0) { if (n == 0) qv.x = q; else qv.y = q; } else { if (n == 0) qv.z = q; else qv.w = q; } }
                    *(u32x4*)(hb + off + bj * HALF) = wv; }
                *(u32x4*)(lob + (off - col0) + lo0) = qv;
                __builtin_amdgcn_sched_barrier(0); }
        }
    }
};

template <class Epi, class Sched, bool ALIGN_EPI = true>
__device__ __forceinline__ void gemm_phase(LAS unsigned char* lds, const Gemm g, const Sched& S, const Epi& E) {
    int tid = threadIdx.x; asm volatile("" : "+v"(tid));
    const int wid = __builtin_amdgcn_readfirstlane(tid >> 6), lane = tid & 63, wr = wid >> 2, wc = wid & 3, fr = lane & 15, fq = lane >> 4;
    const int K = g.K, nt = K / BK;
    unsigned voffA[2], voffB[2];
#pragma unroll
    for (int i = 0; i < 2; ++i) { int R, C; stage_rc(tid * 16 + i * 8192, R, C); const int Rb = Epi::PERM ? ((R & ~31) + perm32(R & 31)) : R;
        voffA[i] = (unsigned)(R * K + C) * 2u; voffB[i] = (unsigned)(Rb * K + C) * 2u; }
    const size_t kstep = (size_t)(BK * 2);
    const size_t hstep = (size_t)HALF * K * 2;
    const size_t tstep = 2 * hstep;
    const unsigned ldsw = (unsigned)wid * 1024u;
    const int aoff = lds_byte(wr * 64 + fr, fq * 8), boff = lds_byte(wc * 32 + fr, fq * 8);
#define PG8_SA(b, h) (((b) * 2 + (h)) * HTB)
#define PG8_SB(b, h) ((4 + (b) * 2 + (h)) * HTB)
#define PG8_STAGE(bufoff, gbase, voff) do { _Pragma("unroll") for (int _i = 0; _i < 2; ++_i) \
        __builtin_amdgcn_global_load_lds((const unsigned*)((const char*)(gbase) + (voff)[_i]), (LAS unsigned*)(lds + (bufoff) + ldsw + _i * 8192), 16, 0, 0); } while (0)
#define PG8_LDA(dst, b, h) do { _Pragma("unroll") for (int m = 0; m < 4; ++m) _Pragma("unroll") for (int k = 0; k < 2; ++k) dst[m][k] = *(const LAS bf16x8*)(lds + PG8_SA(b, h) + aoff + m * 2048 + k * 1024); } while (0)
#define PG8_LDB(dst, b, h) do { _Pragma("unroll") for (int n = 0; n < 2; ++n) _Pragma("unroll") for (int k = 0; k < 2; ++k) dst[n][k] = *(const LAS bf16x8*)(lds + PG8_SB(b, h) + boff + n * 2048 + k * 1024); } while (0)
#define PG8_MMA(ai, bj, At, Bt) do { __builtin_amdgcn_s_setprio(1); _Pragma("unroll") for (int m = 0; m < 4; ++m) _Pragma("unroll") for (int n = 0; n < 2; ++n) _Pragma("unroll") for (int k = 0; k < 2; ++k) \
        acc[ai][bj][m][n] = __builtin_amdgcn_mfma_f32_16x16x32_bf16(Bt[n][k], At[m][k], acc[ai][bj][m][n], 0, 0, 0); __builtin_amdgcn_s_setprio(0); } while (0)
#define PG8_WAIT_V(n) asm volatile("s_waitcnt vmcnt(" #n ")" ::: "memory")
#define PG8_WAIT_L(n) asm volatile("s_waitcnt lgkmcnt(" #n ")" ::: "memory")
#define PG8_BAR __builtin_amdgcn_s_barrier()
#define PG8_SCHED __builtin_amdgcn_sched_barrier(0)
    Unit cur, nxt; int ui = 0;
    if (!S.next(0, cur)) return;
    f32x4 acc[2][2][4][2];
#pragma unroll
    for (int a = 0; a < 2; ++a)
#pragma unroll
        for (int b = 0; b < 2; ++b)
#pragma unroll
            for (int m = 0; m < 4; ++m)
#pragma unroll
                for (int n = 0; n < 2; ++n) acc[a][b][m][n] = (f32x4){0.f, 0.f, 0.f, 0.f};
    bf16x8 At[4][2], B0[2][2], B1[2][2];
    const char* cA = (const char*)g.A + (size_t)cur.pm * tstep; const char* cB = (const char*)g.Bt + (size_t)cur.pn * tstep;
    PG8_STAGE(PG8_SB(0, 0), cB, voffB); PG8_STAGE(PG8_SB(0, 1), cB + hstep, voffB); PG8_STAGE(PG8_SA(0, 0), cA, voffA); PG8_STAGE(PG8_SA(0, 1), cA + hstep, voffA);
    if (wr == 1) PG8_BAR;
    PG8_WAIT_V(2); PG8_BAR;
    PG8_STAGE(PG8_SB(1, 0), cB + kstep, voffB); PG8_STAGE(PG8_SA(1, 0), cA + kstep, voffA); PG8_STAGE(PG8_SB(1, 1), cB + hstep + kstep, voffB);
    PG8_WAIT_V(6); PG8_BAR;
    for (;;) {
        const bool has_next = S.next(ui + 1, nxt);
        const char* nA = has_next ? (const char*)g.A + (size_t)nxt.pm * tstep : cA; const char* nB = has_next ? (const char*)g.Bt + (size_t)nxt.pn * tstep : cB;
        for (int t = 0; t < nt; t += 2) {
            const bool last = (t == nt - 2);
            const char* a1 = cA + (size_t)(t + 1) * kstep;
            const char* a2 = last ? nA : cA + (size_t)(t + 2) * kstep; const char* b2 = last ? nB : cB + (size_t)(t + 2) * kstep;
            const char* a3 = a2 + kstep; const char* b3 = b2 + kstep;
            PG8_LDB(B0, 0, 0); PG8_LDB(B1, 0, 1); PG8_SCHED; PG8_LDA(At, 0, 0); PG8_STAGE(PG8_SA(1, 1), a1 + hstep, voffA);
            PG8_WAIT_V(8); PG8_WAIT_L(0); PG8_BAR; PG8_MMA(0, 0, At, B0); PG8_MMA(0, 1, At, B1); PG8_BAR; PG8_SCHED;
            PG8_LDA(At, 0, 1); PG8_STAGE(PG8_SB(0, 0), b2, voffB); PG8_STAGE(PG8_SB(0, 1), b2 + hstep, voffB); PG8_STAGE(PG8_SA(0, 0), a2, voffA);
            PG8_WAIT_V(8); PG8_WAIT_L(0); PG8_BAR; PG8_MMA(1, 0, At, B0); PG8_MMA(1, 1, At, B1); PG8_BAR; PG8_SCHED;
            PG8_LDB(B0, 1, 0); PG8_LDB(B1, 1, 1); PG8_SCHED; PG8_LDA(At, 1, 0); PG8_STAGE(PG8_SA(0, 1), a2 + hstep, voffA);
            PG8_WAIT_V(8); PG8_WAIT_L(0); PG8_BAR; PG8_MMA(0, 0, At, B0); PG8_MMA(0, 1, At, B1); PG8_BAR; PG8_SCHED;
            PG8_LDA(At, 1, 1); PG8_STAGE(PG8_SB(1, 0), b3, voffB); PG8_STAGE(PG8_SB(1, 1), b3 + hstep, voffB); PG8_STAGE(PG8_SA(1, 0), a3, voffA);
            PG8_WAIT_V(8); PG8_WAIT_L(0); PG8_BAR; PG8_MMA(1, 0, At, B0); PG8_MMA(1, 1, At, B1); PG8_BAR; PG8_SCHED;
        }
        if constexpr (ALIGN_EPI) { if (wr == 0) PG8_BAR; }
        E(acc, cur, wr, wc, fr, fq);
        if (!has_next) break;
#pragma unroll
        for (int a = 0; a < 2; ++a)
#pragma unroll
            for (int b = 0; b < 2; ++b)
#pragma unroll
                for (int m = 0; m < 4; ++m)
#pragma unroll
                    for (int n = 0; n < 2; ++n) acc[a][b][m][n] = (f32x4){0.f, 0.f, 0.f, 0.f};
        cur = nxt; cA = nA; cB = nB; ++ui;
        if constexpr (ALIGN_EPI) { if (wr == 1) PG8_BAR; }
    }
    PG8_WAIT_V(0);
    if constexpr (!ALIGN_EPI) { if (wr == 0) PG8_BAR; }
    PG8_BAR;
#undef PG8_SA
#undef PG8_SB
#undef PG8_STAGE
#undef PG8_LDA
#undef PG8_LDB
#undef PG8_MMA
#undef PG8_WAIT_V
#undef PG8_WAIT_L
#undef PG8_BAR
#undef PG8_SCHED
}
}

namespace att {
constexpr int KROW = 144, KBUF = 64 * KROW;
constexpr int OFF_K = 0, OFF_V = 4 * KBUF, OFF_C = 8 * KBUF, OFF_LUT = OFF_C + SEQ * 4, LUT_N = 320, OFF_FLAG = OFF_LUT + LUT_N * 4;
constexpr int OFF_LUT_SWA = 12 * KBUF;
constexpr float DEAD = -136.f;
enum { M_SB = 0, M_SWA = 1, M_FOX = 2 };

__device__ __forceinline__ float other_half(float x, int hi) {
    const unsigned u = __float_as_uint(x); auto rr = __builtin_amdgcn_permlane32_swap(u, u, false, false);
    return __uint_as_float(hi ? rr[0] : rr[1]);
}
__device__ __forceinline__ f32x16 mfma32(bf16x8 a, bf16x8 b, f32x16 c) { return __builtin_amdgcn_mfma_f32_32x32x16_bf16(a, b, c, 0, 0, 0); }

__device__ __forceinline__ void pv_block(f32x16 (&o)[2], const f32x16& p, const LAS unsigned char* vb) {
#pragma unroll
    for (int j = 0; j < 2; ++j) {
        u32x4 pw; pw.x = cvt_pk(p[8 * j + 0], p[8 * j + 1]); pw.y = cvt_pk(p[8 * j + 2], p[8 * j + 3]); pw.z = cvt_pk(p[8 * j + 4], p[8 * j + 5]); pw.w = cvt_pk(p[8 * j + 6], p[8 * j + 7]);
        const bf16x8 pf = __builtin_bit_cast(bf16x8, pw);
#pragma unroll
        for (int db = 0; db < 2; ++db) { const bf16x8 vf = *(const LAS bf16x8*)(vb + db * 32 * KROW + j * 16); o[db] = mfma32(vf, pf, o[db]); }
    }
}
template <bool DIAG>
__device__ __forceinline__ void sb_block_t(f32x16& s, float& carry, int keybase, int tpos, int hi) {
    float tot = 0.f;
#pragma unroll
    for (int r = 15; r >= 0; --r) {
        const float z = s[r]; const float e = ex2(-z); const float L = lg2(1.f + e);
        const bool valid = !DIAG || (keybase + r < tpos);
        const float lsn = valid ? -(L + z) : 0.f;
        const float a = tot; tot += lsn; s[r] = valid ? (a - L) : -INFINITY;
    }
    const float other = other_half(tot, hi);
    const float base = carry + (hi ? 0.f : other);
#pragma unroll
    for (int r = 0; r < 16; ++r) s[r] = ex2(s[r] + base);
    carry += tot + other;
}
__device__ __forceinline__ void sb_block(f32x16& s, float& carry, int keybase, int tpos, bool diag, int hi) {
    if (diag) { asm volatile("" ::: "memory"); sb_block_t<true>(s, carry, keybase, tpos, hi); }
    else sb_block_t<false>(s, carry, keybase, tpos, hi);
}
__device__ __forceinline__ void sm_tile(f32x16& s0, f32x16& s1, f32x16 (&o)[2], float& m, float& l) {
    float t = fmaxf(s0[0], s1[0]);
#pragma unroll
    for (int r = 1; r < 16; ++r) t = fmaxf(t, fmaxf(s0[r], s1[r]));
    { const unsigned u = __float_as_uint(t); auto rr = __builtin_amdgcn_permlane32_swap(u, u, false, false); t = fmaxf(__uint_as_float(rr[0]), __uint_as_float(rr[1])); }
    const float mn = fmaxf(m, t); const float alpha = ex2(m - mn); m = mn; l *= alpha;
    if (__any(alpha != 1.f)) { o[0] *= alpha; o[1] *= alpha; }
    float sum = 0.f;
#pragma unroll
    for (int r = 0; r < 16; ++r) { s0[r] = ex2(s0[r] - mn); s1[r] = ex2(s1[r] - mn); sum += s0[r] + s1[r]; }
    l += sum;
}

template <int MODE>
__device__ __forceinline__ void attn_unit(LAS unsigned char* lds, const bf16_t* QKV, int ld, int qcol, int kcol, int vcol, bf16_t* OB, int ocol, int b, int qb, float sinkv, float kmax) {
    int tid = threadIdx.x; asm volatile("" : "+v"(tid));
    const int lane = tid & 63, w = __builtin_amdgcn_readfirstlane(tid >> 6), q32 = lane & 31, hi = lane >> 5;
    const int q0 = qb * 256, qw0 = q0 + 32 * w, tpos = qw0 + q32;
    const size_t rowb = (size_t)b * SEQ;
    bf16x8 qf[4];
    { const bf16_t* qp = QKV + (rowb + tpos) * ld + qcol + 8 * hi;
#pragma unroll
      for (int c = 0; c < 4; ++c) qf[c] = *(const bf16x8*)(qp + 16 * c); }
    const int skey = tid >> 3, sch = tid & 7;
    const bf16_t* kg = QKV + (rowb + skey) * ld + kcol + 8 * sch;
    const bf16_t* vg = QKV + (rowb + skey) * ld + vcol + 8 * sch;
    LAS unsigned char* Kb = lds + OFF_K; LAS unsigned char* Vb = lds + (MODE == M_SWA ? 6 * KBUF : OFF_V);
    const LAS float* carr = (const LAS float*)(lds + OFF_C); const LAS float* lut = (const LAS float*)(lds + OFF_LUT_SWA);
    const int kwr = skey * KROW + sch * 16, vwr = (8 * sch) * KROW + skey * 2;
    const int kperm = 16 * ((q32 >> 2) & 1) + 4 * (q32 >> 3) + (q32 & 3);
    const int krd = kperm * KROW + hi * 16, vrd = q32 * KROW + hi * 32;
    const int kt_hi = 4 * qb + 3, kt_lo = (MODE == M_SWA) ? (4 * qb - 2 > 0 ? 4 * qb - 2 : 0) : 0;

#define ATT_LOAD(KR, VR, t) do { KR = *(const u32x4*)(kg + (size_t)(t) * 64 * ld); VR = *(const u32x4*)(vg + (size_t)(t) * 64 * ld); } while (0)
    u32x4 kA, vA, kB, vB;
    if (MODE != M_SWA) { ATT_LOAD(kA, vA, kt_hi); ATT_LOAD(kB, vB, kt_hi - 1); }
    f32x16 o[2]; o[0] = (f32x16)(0.f); o[1] = (f32x16)(0.f);
    float carry = 0.f, m = (MODE == M_SWA) ? sinkv : -INFINITY, l = (MODE == M_SWA && hi == 0) ? 1.f : 0.f;
    float ct = 0.f, zb = 0.f;
    if (MODE == M_FOX) {
        float qq = 0.f;
#pragma unroll
        for (int c = 0; c < 4; ++c)
#pragma unroll
            for (int e = 0; e < 8; ++e) { const float x = __builtin_bit_cast(float, (unsigned)(unsigned short)qf[c][e] << 16); qq += x * x; }
        qq += __shfl_xor(qq, 32);
        zb = sqrtf(qq) * kmax * 1.002f + 0.01f; }
    volatile LAS unsigned* flag = (volatile LAS unsigned*)(lds + OFF_FLAG);
    if (MODE != M_SWA && tid == 0) { flag[0] = 0u; flag[1] = 0u; }
    bool wdead = false; unsigned dw0 = 0u, dw1 = 0u;

#define ATT_WRITE(buf, KR, VR) do { *(LAS u32x4*)(Kb + (buf) * KBUF + kwr) = KR; LAS unsigned short* vp_ = (LAS unsigned short*)(Vb + (buf) * KBUF + vwr); \
        vp_[0 * (KROW / 2)] = (unsigned short)(VR.x & 0xffffu); vp_[1 * (KROW / 2)] = (unsigned short)(VR.x >> 16); vp_[2 * (KROW / 2)] = (unsigned short)(VR.y & 0xffffu); vp_[3 * (KROW / 2)] = (unsigned short)(VR.y >> 16); \
        vp_[4 * (KROW / 2)] = (unsigned short)(VR.z & 0xffffu); vp_[5 * (KROW / 2)] = (unsigned short)(VR.z >> 16); vp_[6 * (KROW / 2)] = (unsigned short)(VR.w & 0xffffu); vp_[7 * (KROW / 2)] = (unsigned short)(VR.w >> 16); } while (0)
#define ATT_COMPUTE(kt_, cur_, par_) do { \
        const int k0 = (kt_) * 64; \
        bool active, diag; \
        if (MODE == M_SB) { active = k0 <= qw0 + 30; diag = k0 + 63 >= qw0; } \
        else if (MODE == M_FOX) { active = k0 <= qw0 + 31; diag = k0 + 63 > qw0; } \
        else { active = (k0 <= qw0 + 31) && (k0 + 63 >= qw0 - 127); diag = true; } \
        if (MODE == M_FOX && active && !wdead && !diag) { \
              \
            const float dmax = carr[k0 + 63];            \
            if (__all(dmax + zb - m <= DEAD)) { wdead = true; if (lane == 0) __hip_atomic_fetch_add((LAS unsigned*)(lds + OFF_FLAG) + (par_), 1u, __ATOMIC_RELAXED, __HIP_MEMORY_SCOPE_WORKGROUP); } \
        } \
        if (active && !wdead) { \
            const LAS unsigned char* kb_ = Kb + (cur_) * KBUF + krd; const LAS unsigned char* vb_ = Vb + (cur_) * KBUF + vrd; \
            f32x16 s0, s1; \
            if (MODE == M_FOX) { \
                  \
                const LAS f32x4* c0 = (const LAS f32x4*)(carr + k0 + 16 * hi); const LAS f32x4* c1 = (const LAS f32x4*)(carr + k0 + 32 + 16 * hi); \
                _Pragma("unroll") for (int i = 0; i < 4; ++i) { const f32x4 a = c0[i], bq = c1[i]; \
                    _Pragma("unroll") for (int j = 0; j < 4; ++j) { s0[4 * i + j] = a[j]; s1[4 * i + j] = bq[j]; } } \
            } else { s0 = (f32x16)(0.f); s1 = (f32x16)(0.f); } \
            _Pragma("unroll") for (int c = 0; c < 4; ++c) { \
                const bf16x8 k0f = *(const LAS bf16x8*)(kb_ + c * 32); const bf16x8 k1f = *(const LAS bf16x8*)(kb_ + 32 * KROW + c * 32); \
                s0 = mfma32(k0f, qf[c], s0); s1 = mfma32(k1f, qf[c], s1); } \
            const int kbase0 = k0 + 16 * hi, kbase1 = k0 + 32 + 16 * hi; \
            if (MODE == M_SB) { \
                sb_block(s1, carry, kbase1, tpos, diag, hi); \
                pv_block(o, s1, vb_ + 64); \
                sb_block(s0, carry, kbase0, tpos, diag, hi); \
                pv_block(o, s0, vb_); \
                  \
                if (__all(carry <= DEAD)) { wdead = true; if (lane == 0) __hip_atomic_fetch_add((LAS unsigned*)(lds + OFF_FLAG) + (par_), 1u, __ATOMIC_RELAXED, __HIP_MEMORY_SCOPE_WORKGROUP); } \
            } else { \
                if (MODE == M_SWA) { \
                    const LAS float* l0 = lut + (tpos - kbase0 + 64 - 15); const LAS float* l1 = lut + (tpos - kbase1 + 64 - 15); \
                    _Pragma("unroll") for (int r = 0; r < 16; ++r) { \
                        const int rel0 = tpos - (kbase0 + r), rel1 = tpos - (kbase1 + r); \
                        s0[r] = (rel0 >= 0 && rel0 < 128) ? s0[r] + l0[15 - r] : -INFINITY; \
                        s1[r] = (rel1 >= 0 && rel1 < 128) ? s1[r] + l1[15 - r] : -INFINITY; } \
                } else if (diag) { asm volatile("" ::: "memory");        \
                    _Pragma("unroll") for (int r = 0; r < 16; ++r) { if (kbase0 + r > tpos) s0[r] = -INFINITY; if (kbase1 + r > tpos) s1[r] = -INFINITY; } \
                } \
                sm_tile(s0, s1, o, m, l); \
                pv_block(o, s1, vb_ + 64); \
                pv_block(o, s0, vb_); \
            } \
        } } while (0)

#define ATT_COMPUTE2(kt_, sa_, sb_, par_) do { \
        const int k0a = (kt_) * 64, k0b = k0a - 64; \
        const bool diagA = (MODE == M_SB) ? (k0a + 63 >= qw0) : (k0a + 63 > qw0), diagB = (MODE == M_SB) ? (k0b + 63 >= qw0) : (k0b + 63 > qw0); \
        const bool fast = (MODE != M_SWA) && !wdead && (k0a <= qw0 + (MODE == M_SB ? 30 : 31));        \
        if (fast && MODE == M_FOX && !diagA) { \
            const float dmax = carr[k0a + 63]; \
            if (__all(dmax + zb - m <= DEAD)) { wdead = true; if (lane == 0) __hip_atomic_fetch_add((LAS unsigned*)(lds + OFF_FLAG) + (par_), 1u, __ATOMIC_RELAXED, __HIP_MEMORY_SCOPE_WORKGROUP); } \
        } \
        if (fast) { if (!wdead) { \
            const LAS unsigned char* kba = Kb + (sa_) * KBUF + krd; const LAS unsigned char* vba = Vb + (sa_) * KBUF + vrd; \
            const LAS unsigned char* kbb = Kb + (sb_) * KBUF + krd; const LAS unsigned char* vbb = Vb + (sb_) * KBUF + vrd; \
            f32x16 a0, a1, b0, b1; \
            if (MODE == M_FOX) { \
                const LAS f32x4* c0 = (const LAS f32x4*)(carr + k0a + 16 * hi); const LAS f32x4* c1 = (const LAS f32x4*)(carr + k0a + 32 + 16 * hi); \
                const LAS f32x4* d0 = (const LAS f32x4*)(carr + k0b + 16 * hi); const LAS f32x4* d1 = (const LAS f32x4*)(carr + k0b + 32 + 16 * hi); \
                _Pragma("unroll") for (int i = 0; i < 4; ++i) { const f32x4 x0 = c0[i], x1 = c1[i], y0 = d0[i], y1 = d1[i]; \
                    _Pragma("unroll") for (int j = 0; j < 4; ++j) { a0[4 * i + j] = x0[j]; a1[4 * i + j] = x1[j]; b0[4 * i + j] = y0[j]; b1[4 * i + j] = y1[j]; } } \
            } else { a0 = (f32x16)(0.f); a1 = (f32x16)(0.f); b0 = (f32x16)(0.f); b1 = (f32x16)(0.f); } \
            _Pragma("unroll") for (int c = 0; c < 4; ++c) { \
                const bf16x8 ka0 = *(const LAS bf16x8*)(kba + c * 32); const bf16x8 ka1 = *(const LAS bf16x8*)(kba + 32 * KROW + c * 32); \
                a0 = mfma32(ka0, qf[c], a0); a1 = mfma32(ka1, qf[c], a1); } \
            _Pragma("unroll") for (int c = 0; c < 4; ++c) { \
                const bf16x8 kb0 = *(const LAS bf16x8*)(kbb + c * 32); const bf16x8 kb1 = *(const LAS bf16x8*)(kbb + 32 * KROW + c * 32); \
                b0 = mfma32(kb0, qf[c], b0); b1 = mfma32(kb1, qf[c], b1); } \
            if (MODE == M_SB) { \
                sb_block(a1, carry, k0a + 32 + 16 * hi, tpos, diagA, hi); pv_block(o, a1, vba + 64); \
                sb_block(a0, carry, k0a + 16 * hi, tpos, diagA, hi); pv_block(o, a0, vba); \
                if (__all(carry <= DEAD)) { wdead = true; if (lane == 0) __hip_atomic_fetch_add((LAS unsigned*)(lds + OFF_FLAG) + (par_), 1u, __ATOMIC_RELAXED, __HIP_MEMORY_SCOPE_WORKGROUP); } \
                else { \
                    sb_block(b1, carry, k0b + 32 + 16 * hi, tpos, diagB, hi); pv_block(o, b1, vbb + 64); \
                    sb_block(b0, carry, k0b + 16 * hi, tpos, diagB, hi); pv_block(o, b0, vbb); \
                    if (__all(carry <= DEAD)) { wdead = true; if (lane == 0) __hip_atomic_fetch_add((LAS unsigned*)(lds + OFF_FLAG) + (par_), 1u, __ATOMIC_RELAXED, __HIP_MEMORY_SCOPE_WORKGROUP); } \
                } \
            } else { \
                if (diagA) { asm volatile("" ::: "memory"); const int ka0_ = k0a + 16 * hi, ka1_ = k0a + 32 + 16 * hi; \
                    _Pragma("unroll") for (int r = 0; r < 16; ++r) { if (ka0_ + r > tpos) a0[r] = -INFINITY; if (ka1_ + r > tpos) a1[r] = -INFINITY; } } \
                sm_tile(a0, a1, o, m, l); pv_block(o, a1, vba + 64); pv_block(o, a0, vba); \
                const float dmaxb = carr[k0b + 63]; \
                if (MODE == M_FOX && !diagB && __all(dmaxb + zb - m <= DEAD)) { wdead = true; if (lane == 0) __hip_atomic_fetch_add((LAS unsigned*)(lds + OFF_FLAG) + (par_), 1u, __ATOMIC_RELAXED, __HIP_MEMORY_SCOPE_WORKGROUP); } \
                else { \
                    if (diagB) { asm volatile("" ::: "memory"); const int kb0_ = k0b + 16 * hi, kb1_ = k0b + 32 + 16 * hi; \
                        _Pragma("unroll") for (int r = 0; r < 16; ++r) { if (kb0_ + r > tpos) b0[r] = -INFINITY; if (kb1_ + r > tpos) b1[r] = -INFINITY; } } \
                    sm_tile(b0, b1, o, m, l); pv_block(o, b1, vbb + 64); pv_block(o, b0, vbb); } \
            } \
        } } else { ATT_COMPUTE(kt_, sa_, par_); ATT_COMPUTE((kt_) - 1, sb_, par_); } \
    } while (0)

    if (MODE == M_SWA) {
        const int nt = kt_hi - kt_lo + 1;
        u32x4 kr[6], vr[6];
#pragma unroll
        for (int t = 0; t < 6; ++t) if (t < nt) ATT_LOAD(kr[t], vr[t], kt_lo + t);
#pragma unroll
        for (int t = 0; t < 6; ++t) if (t < nt) ATT_WRITE(t, kr[t], vr[t]);
        __syncthreads();
        for (int kt = kt_hi; kt >= kt_lo; --kt) { const int slot = kt - kt_lo; ATT_COMPUTE(kt, slot, 0); }
        __syncthreads();
    } else {
        ATT_WRITE(0, kA, vA); ATT_WRITE(1, kB, vB);
        ATT_LOAD(kA, vA, kt_hi - 2); ATT_LOAD(kB, vB, kt_hi - 3);
        __syncthreads();
        int kt = kt_hi;
        for (;;) {
            if (kt - 2 >= kt_lo) { ATT_WRITE(2, kA, vA); ATT_WRITE(3, kB, vB); if (kt - 4 >= kt_lo) { ATT_LOAD(kA, vA, kt - 4); ATT_LOAD(kB, vB, kt - 5); } }
            ATT_COMPUTE2(kt, 0, 1, 0);
            __syncthreads();
            dw0 = flag[0];
            if (dw0 + dw1 >= 8u) break;
            kt -= 2; if (kt < kt_lo) break;
            if (kt - 2 >= kt_lo) { ATT_WRITE(0, kA, vA); ATT_WRITE(1, kB, vB); if (kt - 4 >= kt_lo) { ATT_LOAD(kA, vA, kt - 4); ATT_LOAD(kB, vB, kt - 5); } }
            ATT_COMPUTE2(kt, 2, 3, 1);
            __syncthreads();
            dw1 = flag[1];
            if (dw0 + dw1 >= 8u) break;
            kt -= 2; if (kt < kt_lo) break;
        }
        __syncthreads();
    }
#undef ATT_LOAD
#undef ATT_WRITE
#undef ATT_COMPUTE
#undef ATT_COMPUTE2
    float inv = 1.f;
    if (MODE != M_SB) { const float lt = l + __shfl_xor(l, 32); inv = 1.f / lt; }
    {
        LAS unsigned char* stg = lds + w * (32 * KROW);
#pragma unroll
        for (int db = 0; db < 2; ++db)
#pragma unroll
            for (int a = 0; a < 4; ++a) { u32x2 wv; wv.x = cvt_pk(o[db][4 * a] * inv, o[db][4 * a + 1] * inv); wv.y = cvt_pk(o[db][4 * a + 2] * inv, o[db][4 * a + 3] * inv);
                *(LAS u32x2*)(stg + q32 * KROW + (32 * db + 8 * a + 4 * hi) * 2) = wv; }
        asm volatile("s_waitcnt lgkmcnt(0)" ::: "memory");
        bf16_t* ob = OB + (rowb + qw0) * D_MODEL + ocol;
#pragma unroll
        for (int i = 0; i < 4; ++i) { const int row = i * 8 + (lane >> 3), ch = lane & 7; const u32x4 v = *(const LAS u32x4*)(stg + row * KROW + ch * 16); *(u32x4*)(ob + (size_t)row * D_MODEL + ch * 8) = v; }
        __syncthreads();
    }
}

__device__ __forceinline__ int t5_bucket(int n) {
    if (n < 16) return n;
    int v = 16 + (int)(logf((float)n / 16.f) / 2.0794415416798357f * 16.f);
    return v < 31 ? v : 31;
}
}

constexpr size_t MiB = 1u << 20;
constexpr size_t WS_FFN_IN = 0, WS_FFN_OUT = 44 * MiB, WS_AB_IN = 66 * MiB, WS_AB_OUT = 70 * MiB + MiB / 2, WS_FOX_IN = 72 * MiB + MiB / 2, WS_FOX_OUT = 79 * MiB;
constexpr size_t WS_HB = 96 * MiB, WS_BIG = 160 * MiB, WS_OB = 352 * MiB, WS_F = 416 * MiB, WS_CTL = 419 * MiB, WS_XBUF = 420 * MiB, WS_LO = 421 * MiB, WS_END = 453 * MiB;
constexpr int CNT_OFF = 4096, CNT_WORDS = 6 * 128 * 64;
constexpr int LDS_X_OFF = 131072 + 1024;
constexpr int LDS_ST_OFF = 131072 + 320;
constexpr size_t FFN_IN_BYTES = 11 * MiB, FFN_OUT_BYTES = 5 * MiB + MiB / 2;
constexpr int LDS_BYTES = 147456;
constexpr int N_PHASES = 15;


#define XB_TMO      128
#define XB_XCNT(j)  (256  + 64 * (j))
#define XB_XSUB(j)  (1280 + 64 * (j))
#define XB_XGEN(j)  (2304 + 64 * (j))
#define XB_TOP      3328
#define XB_TOPGEN   3392
#define XCD_BAR_WORDS 3456
#define XB_SPIN_CAP (1u << 18)
__device__ __forceinline__ unsigned xb_ld(unsigned* p)              { return __hip_atomic_load(p, __ATOMIC_RELAXED, __HIP_MEMORY_SCOPE_AGENT); }
__device__ __forceinline__ unsigned xb_add(unsigned* p, unsigned v) { return __hip_atomic_fetch_add(p, v, __ATOMIC_RELAXED, __HIP_MEMORY_SCOPE_AGENT); }
__device__ __forceinline__ unsigned xb_xcc_id() { return (unsigned)__builtin_amdgcn_s_getreg((3 << 11) | 20) & 0xFu; }
#define XB_SPIN(cond, bar) do { unsigned _sp = 0; while (cond) { __builtin_amdgcn_s_sleep(1); \
    if ((++_sp & 255u) == 0u) { if (xb_ld(&(bar)[XB_TMO])) break; if (_sp > XB_SPIN_CAP) { atomicAdd(&(bar)[XB_TMO], 1u); break; } } } } while (0)
__device__ __forceinline__ void xcd_barrier_complete(unsigned* bar, unsigned x, unsigned& nloc, unsigned& nx) {
    const unsigned G = gridDim.x;
    unsigned sum, cnt, mine, sp = 0u;
    for (;;) {
        sum = 0u; cnt = 0u; mine = 0u;
#pragma unroll
        for (unsigned j = 0; j < 16; ++j) { const unsigned c = xb_ld(&bar[XB_XCNT(j)]); sum += c; cnt += (c > 0u) ? 1u : 0u; mine = (j == x) ? c : mine; }
        if (sum == G) break;
        __builtin_amdgcn_s_sleep(1);
        if ((++sp & 255u) == 0u) { if (xb_ld(&bar[XB_TMO])) break; if (sp > XB_SPIN_CAP) { atomicAdd(&bar[XB_TMO], 1u); break; } }
    }
    nloc = mine > 0u ? mine : 1u; nx = cnt > 0u ? cnt : 1u;
}
__device__ __forceinline__ void xcd_barrier(unsigned* bar, volatile LAS unsigned* st) {
    asm volatile("s_waitcnt vmcnt(0)" ::: "memory");
    __syncthreads();
    if (threadIdx.x == 0) {
        const unsigned x = xb_xcc_id();
        __builtin_amdgcn_s_waitcnt(0);
        unsigned nloc = st[0], nx = st[1];
        if (nloc == 0u) { xcd_barrier_complete(bar, x, nloc, nx); st[0] = nloc; st[1] = nx; }
        const unsigned old = xb_add(&bar[XB_XSUB(x)], 1u);
        const unsigned gen = old / nloc;
        if (old + 1u == (gen + 1u) * nloc) {
            __builtin_amdgcn_fence(__ATOMIC_RELEASE, "agent");
            asm volatile("s_waitcnt vmcnt(0)" ::: "memory");
            const unsigned og = xb_add(&bar[XB_TOP], 1u);
            const unsigned tg = og / nx;
            if (og + 1u == (tg + 1u) * nx) xb_add(&bar[XB_TOPGEN], 1u);
            else XB_SPIN(xb_ld(&bar[XB_TOPGEN]) == tg, bar);
            __builtin_amdgcn_fence(__ATOMIC_ACQUIRE, "agent");
            xb_add(&bar[XB_XGEN(x)], 1u);
            asm volatile("s_waitcnt vmcnt(0)" ::: "memory");
        } else {
            XB_SPIN(xb_ld(&bar[XB_XGEN(x)]) == gen, bar);
            __builtin_amdgcn_fence(__ATOMIC_ACQUIRE, "agent");
            asm volatile("s_waitcnt vmcnt(0)" ::: "memory");
        }
    }
    __syncthreads();
}

struct Args { const float* in[14]; float* out; unsigned char* ws; int ph_lo, ph_hi; };

__device__ __forceinline__ float wave_sum(float v) {
#pragma unroll
    for (int o = 1; o < 64; o <<= 1) v += __shfl_xor(v, o);
    return v;
}
__device__ __forceinline__ unsigned f2bf(float f) { unsigned u = __builtin_bit_cast(unsigned, f); return (u + 0x7fffu + ((u >> 16) & 1u)) >> 16; }
__device__ __forceinline__ unsigned pk2(float lo, float hi) { return f2bf(lo) | (f2bf(hi) << 16); }

__device__ __forceinline__ void transpose_item(const float* W, int ldw, int K, bf16_t* WT, int k0, int n0, int drow0, LAS float* scr, int lane) {
#pragma unroll
    for (int i = 0; i < 8; ++i) { const int idx = lane + 64 * i, kk = idx >> 3, c4 = idx & 7; const f32x4 v = *(const f32x4*)(W + (size_t)(k0 + kk) * ldw + n0 + 4 * c4);
        LAS float* d = scr + kk * 33 + 4 * c4; d[0] = v[0]; d[1] = v[1]; d[2] = v[2]; d[3] = v[3]; }
    asm volatile("s_waitcnt lgkmcnt(0)" ::: "memory");
    const int c = lane & 7;
#pragma unroll
    for (int j = 0; j < 4; ++j) { const int n = (lane >> 3) + 8 * j; const LAS float* s = scr + (8 * c) * 33 + n;
        u32x4 o; o.x = pk2(s[0 * 33], s[1 * 33]); o.y = pk2(s[2 * 33], s[3 * 33]); o.z = pk2(s[4 * 33], s[5 * 33]); o.w = pk2(s[6 * 33], s[7 * 33]);
        *(u32x4*)(WT + (size_t)(drow0 + n) * K + k0 + 8 * c) = o; }
    asm volatile("s_waitcnt lgkmcnt(0)" ::: "memory");
}

__global__ void __launch_bounds__(512, 2) mega(Args args) {
    extern __shared__ __attribute__((aligned(16))) unsigned char lds_raw[];
    LAS unsigned char* lds = (LAS unsigned char*)lds_raw;
    cg::grid_group grid = cg::this_grid();
    typedef const __attribute__((address_space(4))) Args* kargp_t;
    if (threadIdx.x < 2) ((volatile LAS unsigned*)(lds + LDS_ST_OFF))[threadIdx.x] = 0u;
    __syncthreads();

    for (int pp = args.ph_lo; pp < args.ph_hi; ++pp) {
        const int p = pp;
        int tid = threadIdx.x; asm volatile("" : "+v"(tid));
        int bid = blockIdx.x; asm volatile("" : "+s"(bid));
        int G = gridDim.x; asm volatile("" : "+s"(G));
        const int lane = tid & 63, wave = __builtin_amdgcn_readfirstlane(tid >> 6);
        const int gw = bid * 8 + wave, NGW = G * 8;
        kargp_t ap = (kargp_t)__builtin_amdgcn_kernarg_segment_ptr(); asm volatile("" : "+s"(ap));
        unsigned char* ws = ap->ws;
        bf16_t* HB = (bf16_t*)(ws + WS_HB); bf16_t* BIG = (bf16_t*)(ws + WS_BIG); bf16_t* OB = (bf16_t*)(ws + WS_OB); float* FB = (float*)(ws + WS_F);
        float* out = ap->out;
        if (EN_P0 && p == 0) {
            LAS float* scr = (LAS float*)(lds + wave * 16384);
            constexpr int I_IN = 16 * 176, I_OUT = 44 * 32, I_ABI = 16 * 72, I_O = 16 * 32, I_FXI = 16 * 96;
            constexpr int NITEMS = 4 * I_IN + 4 * I_OUT + I_ABI + I_O + I_FXI + I_O;
            for (int it = gw; it < NITEMS; it += NGW) {
                int r = it; const float* src; int ldw, K, nblk; bf16_t* dst; int mode = 0;
                if (r < 4 * I_IN) { const int idx = r / I_IN; r -= idx * I_IN; src = ap->in[(idx & 1) ? 5 : 3] + (size_t)(idx >> 1) * D_MODEL * 2 * D_FF; ldw = 2 * D_FF; K = D_MODEL; nblk = 176; dst = (bf16_t*)(ws + WS_FFN_IN + idx * FFN_IN_BYTES); mode = 1; }
                else if ((r -= 4 * I_IN) < 4 * I_OUT) { const int idx = r / I_OUT; r -= idx * I_OUT; src = ap->in[(idx & 1) ? 6 : 4] + (size_t)(idx >> 1) * D_FF * D_MODEL; ldw = D_MODEL; K = D_FF; nblk = 32; dst = (bf16_t*)(ws + WS_FFN_OUT + idx * FFN_OUT_BYTES); }
                else if ((r -= 4 * I_OUT) < I_ABI) { src = ap->in[7]; ldw = AB_IN; K = D_MODEL; nblk = 72; dst = (bf16_t*)(ws + WS_AB_IN); }
                else if ((r -= I_ABI) < I_O) { src = ap->in[8]; ldw = D_MODEL; K = D_MODEL; nblk = 32; dst = (bf16_t*)(ws + WS_AB_OUT); }
                else if ((r -= I_O) < I_FXI) { src = ap->in[10]; ldw = FOX_IN; K = D_MODEL; nblk = 96; dst = (bf16_t*)(ws + WS_FOX_IN); }
                else { r -= I_FXI; src = ap->in[12]; ldw = D_MODEL; K = D_MODEL; nblk = 32; dst = (bf16_t*)(ws + WS_FOX_OUT); }
                const int kb = r / nblk, nb = r - kb * nblk, n0 = 32 * nb;
                int drow0 = n0;
                if (mode == 1) { const int j = n0 < D_FF ? n0 : n0 - D_FF; drow0 = 256 * (j >> 7) + (j & 127) + (n0 < D_FF ? 0 : 128); }
                transpose_item(src, ldw, K, dst, 64 * kb, n0, drow0, scr, lane);
            }
            if (bid == 0) { unsigned* ctl = (unsigned*)(ws + WS_CTL); for (int i = tid; i < XCD_BAR_WORDS; i += 512) ctl[i] = 0u; }
            { unsigned* ctl = (unsigned*)(ws + WS_CTL) + CNT_OFF; for (int i = bid * 512 + tid; i < CNT_WORDS; i += G * 512) ctl[i] = 0u; }
            { bf16_t* dst = (bf16_t*)(ws + WS_FOX_IN); const float* src = ap->in[10];
              for (int i = bid * 512 + tid; i < 16 * D_MODEL; i += G * 512) { const int n = i >> 10, k = i & 1023; dst[(size_t)(FOX_QKV + n) * D_MODEL + k] = (bf16_t)f2bf(src[(size_t)k * FOX_IN + FOX_QKV + n]); } }
            for (int mrow = gw; mrow < MTOK; mrow += NGW) {
                const float* xr = ap->in[0] + (size_t)mrow * D_MODEL; bf16_t* hr = HB + (size_t)mrow * D_MODEL; unsigned char* lr = ws + WS_LO + (size_t)mrow * D_MODEL;
#pragma unroll
                for (int j = 0; j < 2; ++j) { const int c8 = 8 * (lane + 64 * j); u32x4 wv; u32x2 qv;
#pragma unroll
                    for (int n = 0; n < 2; ++n) { const f32x4 v = *(const f32x4*)(xr + c8 + 4 * n); const unsigned w0 = cvt_pk(v[0], v[1]), w1 = cvt_pk(v[2], v[3]);
                        const float l0 = (v[0] - __builtin_bit_cast(float, w0 << 16)) * 4096.f + 128.5f, l1 = (v[1] - __builtin_bit_cast(float, w0 & 0xffff0000u)) * 4096.f + 128.5f;
                        const float l2 = (v[2] - __builtin_bit_cast(float, w1 << 16)) * 4096.f + 128.5f, l3 = (v[3] - __builtin_bit_cast(float, w1 & 0xffff0000u)) * 4096.f + 128.5f;
                        const unsigned q = (unsigned)(int)fminf(fmaxf(l0, 0.f), 255.f) | ((unsigned)(int)fminf(fmaxf(l1, 0.f), 255.f) << 8) | ((unsigned)(int)fminf(fmaxf(l2, 0.f), 255.f) << 16) | ((unsigned)(int)fminf(fmaxf(l3, 0.f), 255.f) << 24);
                        if (n == 0) { wv.x = w0; wv.y = w1; qv.x = q; } else { wv.z = w0; wv.w = w1; qv.y = q; } }
                    *(u32x4*)(hr + c8) = wv; *(u32x2*)(lr + (c8 & ~255) + 64 * ((c8 >> 5) & 3) + 16 * ((c8 >> 3) & 3) + 8 * ((c8 >> 7) & 1)) = qv; }
            }
        } else {
            const int L = (p - 1) / 7, s = (p - 1) % 7;
            if (EN_G1 && (s == 0 || s == 5)) {
                const int idx = L * 2 + (s == 5 ? 1 : 0);
                pg8::Gemm g{HB, (const bf16_t*)(ws + WS_FFN_IN + idx * FFN_IN_BYTES), MTOK, 2 * D_FF, D_MODEL};
                pg8::StaticOrder S; S.init(MTOK, 2 * D_FF, G, bid, WGM_FFN_IN);
                pg8::EpiSwiGLU E{BIG, D_FF};
                pg8::gemm_phase<pg8::EpiSwiGLU, pg8::StaticOrder>(lds, g, S, E);
            } else if (EN_G2 && (s == 1 || s == 4 || s == 6)) {
                const bf16_t* A; const bf16_t* Bt; int K; float cs;
                const int li = L * 3 + (s == 1 ? 0 : (s == 4 ? 1 : 2));
                if (s == 4) { A = OB; Bt = (const bf16_t*)(ws + (L == 0 ? WS_AB_OUT : WS_FOX_OUT)); K = D_MODEL; cs = 1.f; }
                else { const int idx = L * 2 + (s == 6 ? 1 : 0); A = BIG; Bt = (const bf16_t*)(ws + WS_FFN_OUT + idx * FFN_OUT_BYTES); K = D_FF; cs = 0.5f; }
                pg8::Gemm g{A, Bt, MTOK, D_MODEL, K};
                pg8::StaticOrder S; S.init(MTOK, D_MODEL, G, bid, WGM_OUT);
                pg8::EpiLnFused E{(L == 1 && s == 6) ? out : (float*)nullptr, HB, ws + WS_LO, ALPHA, cs, ap->in[1] + (size_t)li * D_MODEL, ap->in[2] + (size_t)li * D_MODEL,
                                  (unsigned long long*)(ws + WS_XBUF), (unsigned*)(ws + WS_CTL) + CNT_OFF + li * 128 * 64, lds + LDS_X_OFF};
                pg8::gemm_phase<pg8::EpiLnFused, pg8::StaticOrder>(lds, g, S, E);
            } else if (EN_G3 && s == 2) {
                const bool ab = (L == 0);
                if (!ab) {
                    const bf16_t* wf = (const bf16_t*)(ws + WS_FOX_IN) + (size_t)FOX_QKV * D_MODEL;
                    for (int task = gw; task < MTOK / 16; task += NGW) {
                        const bf16_t* ap_ = HB + (size_t)(task * 16 + (lane & 15)) * D_MODEL + 8 * (lane >> 4); const bf16_t* bp_ = wf + (size_t)(lane & 15) * D_MODEL + 8 * (lane >> 4);
                        f32x4 fa = (f32x4){0.f, 0.f, 0.f, 0.f};
#pragma unroll 8
                        for (int k = 0; k < D_MODEL; k += 32) fa = __builtin_amdgcn_mfma_f32_16x16x32_bf16(*(const bf16x8*)(ap_ + k), *(const bf16x8*)(bp_ + k), fa, 0, 0, 0);
                        *(f32x4*)(FB + (size_t)(lane & 15) * MTOK + task * 16 + 4 * (lane >> 4)) = fa;
                    }
                }
                pg8::Gemm g{HB, (const bf16_t*)(ws + (ab ? WS_AB_IN : WS_FOX_IN)), MTOK, ab ? AB_IN : FOX_QKV, D_MODEL};
                pg8::StaticOrder S; S.init(MTOK, g.N, G, bid, WGM_QKV);
                pg8::EpiQKV E{BIG, ab ? AB_IN : FOX_QKV, ab ? 0xC3u : 0xFu, FB, -1};
                pg8::gemm_phase<pg8::EpiQKV, pg8::StaticOrder>(lds, g, S, E);
            } else if (s == 3) {
                if (L == 0) {
                    for (int job = bid; job < 256; job += G) {
                        if (EN_SB) { const int bh = job >> 1, which = job & 1, b = bh >> 3, h = bh & 7;
                          for (int i = 0; i < 4; ++i) { const int qb = which ? (i == 0 ? 6 : i == 1 ? 5 : i == 2 ? 2 : 1) : (i == 0 ? 7 : i == 1 ? 4 : i == 2 ? 3 : 0);
                              att::attn_unit<att::M_SB>(lds, BIG, AB_IN, h * 64, 512 + h * 64, 1024 + h * 64, OB, h * 64, b, qb, 0.f, 0.f); } }
                        if (EN_SWA) for (int i = 0; i < 4; ++i) { const int idx = job * 4 + i, qb = idx & 7, hq = (idx >> 3) & 7, b = idx >> 6;
                            LAS float* lut = (LAS float*)(lds + att::OFF_LUT_SWA);
                            if (tid < att::LUT_N) { const int rel = tid - 64; lut[tid] = (rel >= 0 && rel < 128) ? ap->in[13][att::t5_bucket(rel) * 8 + hq] * LOG2E : 0.f; }
                            const float sinkv = ap->in[9][hq] * LOG2E;
                            att::attn_unit<att::M_SWA>(lds, BIG, AB_IN, 1536 + hq * 64, 2048 + (hq >> 2) * 64, 2176 + (hq >> 2) * 64, OB, 512 + hq * 64, b, qb, sinkv, 0.f); }
                    }
                } else {
                    if (EN_FOX) for (int job = bid; job < 256; job += G) {
                        const int b = job >> 4, h = job & 15;
                        LAS float* carr = (LAS float*)(lds + att::OFF_C); LAS float* wsum = (LAS float*)(lds + att::OFF_LUT);
                        const float bfh = ap->in[11][h];
                        float v[4]; const f32x4 fv = *(const f32x4*)(FB + (size_t)h * MTOK + (size_t)b * SEQ + tid * 4);
#pragma unroll
                        for (int i = 0; i < 4; ++i) { const float f = fv[i] + bfh; v[i] = (fminf(f, 0.f) - log1pf(expf(-fabsf(f)))) * LOG2E; }
                        v[1] += v[0]; v[2] += v[1]; v[3] += v[2];
                        float x = v[3];
#pragma unroll
                        for (int o = 1; o < 64; o <<= 1) { const float y = __shfl_up(x, o); if (lane >= o) x += y; }
                        float excl = __shfl_up(x, 1); if (lane == 0) excl = 0.f;
                        float kn = 0.f;
                        for (int i = 0; i < 4; ++i) { const u32x4* kp = (const u32x4*)(BIG + ((size_t)b * SEQ + tid * 4 + i) * FOX_QKV + 1024 + h * 64); float ss = 0.f;
#pragma unroll
                            for (int c = 0; c < 8; ++c) { const u32x4 kv = kp[c];
#pragma unroll
                                for (int e = 0; e < 4; ++e) { const float lo = __builtin_bit_cast(float, kv[e] << 16), hi2 = __builtin_bit_cast(float, kv[e] & 0xffff0000u); ss += lo * lo + hi2 * hi2; } }
                            kn = fmaxf(kn, ss); }
#pragma unroll
                        for (int o = 1; o < 64; o <<= 1) kn = fmaxf(kn, __shfl_xor(kn, o));
                        if (lane == 63) { wsum[wave] = x; wsum[8 + wave] = kn; }
                        __syncthreads();
                        float woff = 0.f, kmax = 0.f;
                        for (int i = 0; i < wave; ++i) woff += wsum[i];
                        for (int i = 0; i < 8; ++i) kmax = fmaxf(kmax, wsum[8 + i]);
                        kmax = sqrtf(kmax);
#pragma unroll
                        for (int i = 0; i < 4; ++i) carr[tid * 4 + i] = -(v[i] + excl + woff);
                        __syncthreads();
                        for (int qb = 7; qb >= 0; --qb)
                            att::attn_unit<att::M_FOX>(lds, BIG, FOX_QKV, h * 64, 1024 + h * 64, 2048 + h * 64, OB, h * 64, b, qb, 0.f, kmax);
                        __syncthreads();
                    }
                }
            }
        }
        if (pp + 1 < args.ph_hi) {
            if (pp == 0) { grid.sync();
                if (threadIdx.x == 0) (void)xb_add((unsigned*)(ap->ws + WS_CTL) + XB_XCNT(xb_xcc_id()), 1u); }
            else xcd_barrier((unsigned*)(ap->ws + WS_CTL), (volatile LAS unsigned*)(lds + LDS_ST_OFF));
        }
    }
}

extern "C" void kernel_launch(void* const* d_in, const int* in_sizes, int n_in, void* d_out, int out_size, void* d_ws, size_t ws_size, hipStream_t stream) {
    static int grid = 0;
    if (grid == 0) {
        if (n_in != 14 || out_size != MTOK * D_MODEL || ws_size < WS_END) { fprintf(stderr, "kernel_launch: unexpected problem (n_in %d, out %d, ws %zu)\n", n_in, out_size, ws_size); grid = -1; return; }
        int dev = 0, cus = 0, per_cu = 0;
        hipGetDevice(&dev); hipDeviceGetAttribute(&cus, hipDeviceAttributeMultiprocessorCount, dev);
        if (hipFuncSetAttribute((const void*)mega, hipFuncAttributeMaxDynamicSharedMemorySize, LDS_BYTES) != hipSuccess) { fprintf(stderr, "kernel_launch: hipFuncSetAttribute failed\n"); grid = -1; return; }
        if (hipOccupancyMaxActiveBlocksPerMultiprocessor(&per_cu, (const void*)mega, 512, LDS_BYTES) != hipSuccess || per_cu < 1) per_cu = 1;
        (void)hipGetLastError();
        grid = cus * per_cu;
        if (grid > 256) grid = 256;
        if (grid != 256) { fprintf(stderr, "kernel_launch: the fused LayerNorm epilogues need exactly 256 resident workgroups (got %d); nothing launched\n", grid); grid = -1; return; }
    }
    if (grid < 0) return;
    Args a{};
    for (int i = 0; i < 14; ++i) a.in[i] = (const float*)d_in[i];
    a.out = (float*)d_out; a.ws = (unsigned char*)d_ws;
#if MK_N_LAUNCHES == 1
    a.ph_lo = 0; a.ph_hi = N_PHASES;
    void* kargs[] = {&a};
    hipError_t e = hipLaunchCooperativeKernel((const void*)mega, dim3(grid), dim3(512), kargs, LDS_BYTES, stream);
    if (e != hipSuccess) fprintf(stderr, "cooperative launch failed: %s (grid %d)\n", hipGetErrorString(e), grid);
#else
    for (int p = 0; p < N_PHASES; ++p) { a.ph_lo = p; a.ph_hi = p + 1; hipLaunchKernelGGL(mega, dim3(grid), dim3(512), LDS_BYTES, stream, a); }
#endif
}
```

```cpp
#include <hip/hip_runtime.h>
#include <hip/hip_cooperative_groups.h>
#include <cstdint>
#include <cstdio>
#include <cmath>
namespace cg = cooperative_groups;

#ifndef MK_N_LAUNCHES
#define MK_N_LAUNCHES 1
#endif

#ifndef EN_P0
#define EN_P0 1
#endif
#ifndef EN_G1
#define EN_G1 1
#endif
#ifndef EN_G2
#define EN_G2 1
#endif
#ifndef EN_LN
#define EN_LN 1
#endif
#ifndef EN_G3
#define EN_G3 1
#endif
#ifndef EN_SB
#define EN_SB 1
#endif
#ifndef EN_SWA
#define EN_SWA 1
#endif
#ifndef EN_FOX
#define EN_FOX 1
#endif
#ifndef WGM_FFN_IN
#define WGM_FFN_IN 4
#endif
#ifndef WGM_OUT
#define WGM_OUT 4
#endif
#ifndef WGM_QKV
#define WGM_QKV 4
#endif
#define LAS __attribute__((address_space(3)))
typedef unsigned short bf16_t;
typedef short bf16x8 __attribute__((ext_vector_type(8)));
typedef float f32x2 __attribute__((ext_vector_type(2)));
typedef float f32x4 __attribute__((ext_vector_type(4)));
typedef float f32x16 __attribute__((ext_vector_type(16)));
typedef unsigned u32x2 __attribute__((ext_vector_type(2)));
typedef unsigned u32x4 __attribute__((ext_vector_type(4)));
typedef __bf16 bf16x2_t __attribute__((ext_vector_type(2)));

constexpr int D_MODEL = 1024, BATCH = 16, SEQ = 2048, MTOK = BATCH * SEQ, D_FF = 2816;
constexpr int AB_IN = 2304, FOX_QKV = 3072, FOX_IN = 3088, FOX_NPAD = 3328;
constexpr float LOG2E = 1.4426950408889634f;
constexpr float QSCALE = 0.125f * LOG2E;
constexpr float ALPHA = 1.4142135623730951f;
constexpr float LN_EPS = 1e-5f;

__device__ __forceinline__ unsigned cvt_pk(float lo, float hi) { f32x2 v = {lo, hi}; bf16x2_t b = __builtin_convertvector(v, bf16x2_t); return __builtin_bit_cast(unsigned, b); }
__device__ __forceinline__ float ex2(float x) { return __builtin_amdgcn_exp2f(x); }
__device__ __forceinline__ float lg2(float x) { return __builtin_amdgcn_logf(x); }

namespace pg8 {
constexpr int BM = 256, BK = 64, HALF = 128, HTB = HALF * BK * 2, STAGE_BYTES = 8 * HTB, NXCD = 8;
__host__ __device__ __forceinline__ int lds_byte(int r, int c) { const int st = (r >> 4) * 2 + (c >> 5), rr = r & 15, cc = c & 31, ob = rr * 64 + cc * 2; return st * 1024 + (ob ^ (((ob >> 9) & 1) << 5)); }
__host__ __device__ __forceinline__ void stage_rc(int b, int& R, int& C) { const int st = b / 1024, sb = b % 1024, swz = sb ^ (((sb >> 9) & 1) << 5); R = (st >> 1) * 16 + swz / 64; C = (st & 1) * 32 + (swz % 64) / 2; }
__host__ __device__ __forceinline__ int perm32(int rho) { const int n = rho >> 4, i = rho & 15; return 8 * (i >> 2) + 4 * n + (i & 3); }

struct Unit { int pm, pn; };
struct Gemm { const bf16_t* A; const bf16_t* Bt; int M, N, K; };

struct StaticOrder {
    int nM, nN, nwg, G, c, WGM;
    __host__ __device__ void init(int M, int N, int G_, int c_, int wgm_) { nM = M / BM; nN = N / BM; nwg = nM * nN; G = G_; c = c_; WGM = wgm_; }
    __host__ __device__ bool next(int i, Unit& u) const {
        const long L = (long)i * G + c; if (L >= nwg) return false;
        int wgid = (int)L; { const int q = nwg / NXCD, r = nwg % NXCD, xcd = wgid % NXCD, off = wgid / NXCD; wgid = (xcd < r ? xcd * (q + 1) : r * (q + 1) + (xcd - r) * q) + off; }
        const int nig = WGM * nN, gid = wgid / nig, fm = gid * WGM, gsz = (nM - fm) < WGM ? (nM - fm) : WGM;
        u.pm = fm + ((wgid % nig) % gsz); u.pn = (wgid % nig) / gsz; return true;
    }
};

struct EpiSwiGLU {
    static constexpr bool PERM = true;
    bf16_t* O; int ldc;
    __device__ __forceinline__ void operator()(const f32x4 (&acc)[2][2][4][2], const Unit& u, int wr, int wc, int fr, int fq) const {
        const int row0 = u.pm * BM + wr * 64 + fr; const int col0 = u.pn * HALF + wc * 32 + 8 * fq;
#pragma unroll
        for (int ai = 0; ai < 2; ++ai)
#pragma unroll
            for (int m = 0; m < 4; ++m) {
                bf16_t* rowp = O + (size_t)(row0 + ai * HALF + m * 16) * ldc + col0;
                float v[8];
#pragma unroll
                for (int n = 0; n < 2; ++n)
#pragma unroll
                    for (int j = 0; j < 4; ++j) { const float g = acc[ai][0][m][n][j], up = acc[ai][1][m][n][j];
                        v[n * 4 + j] = g * __builtin_amdgcn_rcpf(1.f + ex2(-LOG2E * g)) * up; }
                u32x4 w; w.x = cvt_pk(v[0], v[1]); w.y = cvt_pk(v[2], v[3]); w.z = cvt_pk(v[4], v[5]); w.w = cvt_pk(v[6], v[7]);
                *(u32x4*)rowp = w;
            }
    }
};
struct EpiQKV {
    static constexpr bool PERM = true;
    bf16_t* O; int ldc; unsigned qmask; float* F; int ftile;
    __device__ __forceinline__ void operator()(const f32x4 (&acc)[2][2][4][2], const Unit& u, int wr, int wc, int fr, int fq) const {
        const int row0 = u.pm * BM + wr * 64 + fr;
        if (u.pn == ftile) {
            if (wc == 0 && fq < 2) {
#pragma unroll
                for (int ai = 0; ai < 2; ++ai)
#pragma unroll
                    for (int m = 0; m < 4; ++m) { float* fp = F + (size_t)(row0 + ai * HALF + m * 16) * 16 + 8 * fq; *(f32x4*)fp = acc[ai][0][m][0]; *(f32x4*)(fp + 4) = acc[ai][0][m][1]; }
            }
            return;
        }
        const float sc = ((qmask >> u.pn) & 1u) ? QSCALE : 1.f;
        const int col0 = u.pn * BM + wc * 32 + 8 * fq;
#pragma unroll
        for (int ai = 0; ai < 2; ++ai)
#pragma unroll
            for (int m = 0; m < 4; ++m) { bf16_t* rowp = O + (size_t)(row0 + ai * HALF + m * 16) * ldc + col0;
#pragma unroll
                for (int bj = 0; bj < 2; ++bj) { const f32x4 v0 = acc[ai][bj][m][0] * sc, v1 = acc[ai][bj][m][1] * sc;
                    u32x4 w; w.x = cvt_pk(v0[0], v0[1]); w.y = cvt_pk(v0[2], v0[3]); w.z = cvt_pk(v1[0], v1[1]); w.w = cvt_pk(v1[2], v1[3]);
                    *(u32x4*)(rowp + bj * HALF) = w; } }
    }
};
struct EpiLnFused {
    static constexpr bool PERM = true;
    float* out32; bf16_t* hb; unsigned char* lob; float alpha, cs; const float* g; const float* b;
    unsigned long long* xbuf; unsigned* cnt; LAS unsigned char* xl;
    __device__ __forceinline__ void operator()(f32x4 (&acc)[2][2][4][2], const Unit& u, int wr, int wc, int fr, int fq) const {
        const int col0 = u.pn * BM + wc * 32 + 8 * fq; const int lo0 = u.pn * BM + wc * 64 + fq * 16;
        const int wid = wr * 4 + wc, lane = fq * 16 + fr, tid = wid * 64 + lane;
        LAS f32x2* P = (LAS f32x2*)xl; LAS f32x2* S = (LAS f32x2*)(xl + 8192); volatile LAS unsigned* flag = (volatile LAS unsigned*)(xl + 8192 + 2048);
        {
        const bf16_t* hbp = hb; const unsigned char* lobp = lob;
#pragma unroll
        for (int ai = 0; ai < 2; ++ai) {
            u32x4 hv[4][2]; u32x4 lv[4];
#pragma unroll
            for (int m = 0; m < 4; ++m) { const size_t rowo = (size_t)(u.pm * BM + ai * HALF + wr * 64 + m * 16 + fr) * D_MODEL; const size_t off = rowo + col0;
                lv[m] = *(const u32x4*)(lobp + rowo + lo0);
#pragma unroll
                for (int bj = 0; bj < 2; ++bj) hv[m][bj] = *(const u32x4*)(hbp + off + bj * HALF); }
#pragma unroll
            for (int m = 0; m < 4; ++m) {
#pragma unroll
                for (int bj = 0; bj < 2; ++bj)
#pragma unroll
                    for (int n = 0; n < 2; ++n) { const unsigned h0 = n ? hv[m][bj].z : hv[m][bj].x, h1 = n ? hv[m][bj].w : hv[m][bj].y; const unsigned lw = bj ? (n ? lv[m].w : lv[m].z) : (n ? lv[m].y : lv[m].x); f32x4 r;
                        r[0] = __builtin_bit_cast(float, h0 << 16) - 0.03125f + (float)(lw & 0xffu) * 0.000244140625f;
                        r[1] = __builtin_bit_cast(float, h0 & 0xffff0000u) - 0.03125f + (float)((lw >> 8) & 0xffu) * 0.000244140625f;
                        r[2] = __builtin_bit_cast(float, h1 << 16) - 0.03125f + (float)((lw >> 16) & 0xffu) * 0.000244140625f;
                        r[3] = __builtin_bit_cast(float, h1 & 0xffff0000u) - 0.03125f + (float)(lw >> 24) * 0.000244140625f;
                        acc[ai][bj][m][n] = r * alpha + acc[ai][bj][m][n] * cs; }
                asm volatile("" : "+v"(acc[ai][0][m][0]), "+v"(acc[ai][0][m][1]), "+v"(acc[ai][1][m][0]), "+v"(acc[ai][1][m][1])); }
            asm volatile("" : "+s"(hbp), "+s"(lobp) : "v"(acc[ai][1][3][1][3]) : "memory");
        }
        }
#pragma unroll
        for (int ai = 0; ai < 2; ++ai)
#pragma unroll
            for (int m = 0; m < 4; ++m) {
                float s1 = 0.f, s2 = 0.f;
#pragma unroll
                for (int bj = 0; bj < 2; ++bj)
#pragma unroll
                    for (int n = 0; n < 2; ++n) { const f32x4 x = acc[ai][bj][m][n]; s1 += (x[0] + x[1]) + (x[2] + x[3]); s2 += (x[0] * x[0] + x[1] * x[1]) + (x[2] * x[2] + x[3] * x[3]); }
                { auto a16 = __builtin_amdgcn_permlane16_swap(__float_as_uint(s1), __float_as_uint(s1), false, false); s1 = __uint_as_float(a16[0]) + __uint_as_float(a16[1]);
                  auto a32 = __builtin_amdgcn_permlane32_swap(__float_as_uint(s1), __float_as_uint(s1), false, false); s1 = __uint_as_float(a32[0]) + __uint_as_float(a32[1]);
                  auto b16 = __builtin_amdgcn_permlane16_swap(__float_as_uint(s2), __float_as_uint(s2), false, false); s2 = __uint_as_float(b16[0]) + __uint_as_float(b16[1]);
                  auto b32 = __builtin_amdgcn_permlane32_swap(__float_as_uint(s2), __float_as_uint(s2), false, false); s2 = __uint_as_float(b32[0]) + __uint_as_float(b32[1]); }
                if (fq == 0) P[(ai * HALF + wr * 64 + m * 16 + fr) * 4 + wc] = (f32x2){s1, s2};
                __builtin_amdgcn_sched_barrier(0);
            }
        asm volatile("s_waitcnt lgkmcnt(0)" ::: "memory"); __builtin_amdgcn_s_barrier(); asm volatile("" ::: "memory");
        unsigned* pc = cnt + 64 * u.pm;
        if (tid < 256) { const f32x2 a = P[tid * 4 + 0], bq = P[tid * 4 + 1], c = P[tid * 4 + 2], d = P[tid * 4 + 3];
            const float t1 = (a.x + bq.x) + (c.x + d.x), t2 = (a.y + bq.y) + (c.y + d.y);
            __hip_atomic_store(xbuf + ((size_t)(u.pm * BM + tid) * 4 + u.pn), ((unsigned long long)__float_as_uint(t2) << 32) | __float_as_uint(t1), __ATOMIC_RELAXED, __HIP_MEMORY_SCOPE_AGENT); }
        asm volatile("s_waitcnt vmcnt(0)" ::: "memory");
        if (wid < 4 && lane == 0) __hip_atomic_fetch_add(pc, 1u, __ATOMIC_RELAXED, __HIP_MEMORY_SCOPE_AGENT);
        if (wid == 0) {
            for (unsigned sp = 0; sp < (1u << 20); ++sp) {
                if ((unsigned)__builtin_amdgcn_readfirstlane(__hip_atomic_load(pc, __ATOMIC_RELAXED, __HIP_MEMORY_SCOPE_AGENT)) >= 16u) break;
                __builtin_amdgcn_s_sleep(2);
            }
            __builtin_amdgcn_fence(__ATOMIC_ACQUIRE, "agent");
            if (lane == 0) flag[0] = 1u;
        }
        asm volatile("s_waitcnt vmcnt(0) lgkmcnt(0)" ::: "memory"); __builtin_amdgcn_s_barrier(); asm volatile("" ::: "memory");
        if (tid < 256) { const unsigned long long* slot = xbuf + (size_t)(u.pm * BM + tid) * 4; float t1 = 0.f, t2 = 0.f;
#pragma unroll
            for (int t = 0; t < 4; ++t) { const unsigned long long w = __hip_atomic_load(slot + t, __ATOMIC_RELAXED, __HIP_MEMORY_SCOPE_AGENT); t1 += __uint_as_float((unsigned)w); t2 += __uint_as_float((unsigned)(w >> 32)); }
            const float mean = t1 * (1.f / D_MODEL); const float var = fmaxf(t2 * (1.f / D_MODEL) - mean * mean, 0.f);
            S[tid] = (f32x2){mean, 1.f / sqrtf(var + LN_EPS)}; }
        asm volatile("s_waitcnt lgkmcnt(0)" ::: "memory"); __builtin_amdgcn_s_barrier(); asm volatile("" ::: "memory");
        f32x4 gv[2][2], bv[2][2];
#pragma unroll
        for (int bj = 0; bj < 2; ++bj)
#pragma unroll
            for (int n = 0; n < 2; ++n) { gv[bj][n] = *(const f32x4*)(g + col0 + bj * HALF + n * 4); bv[bj][n] = *(const f32x4*)(b + col0 + bj * HALF + n * 4); }
        if (out32) {
#pragma unroll
        for (int ai = 0; ai < 2; ++ai)
#pragma unroll
            for (int m = 0; m < 4; ++m) { const int rt = ai * HALF + wr * 64 + m * 16 + fr; const f32x2 st = S[rt]; const size_t off = (size_t)(u.pm * BM + rt) * D_MODEL + col0;
#pragma unroll
                for (int bj = 0; bj < 2; ++bj)
#pragma unroll
                    for (int n = 0; n < 2; ++n) *(f32x4*)(out32 + off + bj * HALF + n * 4) = (acc[ai][bj][m][n] - st.x) * st.y * gv[bj][n] + bv[bj][n];
                __builtin_amdgcn_sched_barrier(0); }
        } else {
#pragma unroll
        for (int ai = 0; ai < 2; ++ai)
#pragma unroll
            for (int m = 0; m < 4; ++m) { const int rt = ai * HALF + wr * 64 + m * 16 + fr; const f32x2 st = S[rt]; const size_t off = (size_t)(u.pm * BM + rt) * D_MODEL + col0;
                u32x4 qv;
#pragma unroll
                for (int bj = 0; bj < 2; ++bj) { u32x4 wv;
#pragma unroll
                    for (int n = 0; n < 2; ++n) { const f32x4 y = (acc[ai][bj][m][n] - st.x) * st.y * gv[bj][n] + bv[bj][n];
                        const unsigned w0 = cvt_pk(y[0], y[1]), w1 = cvt_pk(y[2], y[3]);
                        const float l0 = (y[0] - __builtin_bit_cast(float, w0 << 16)) * 4096.f + 128.5f, l1 = (y[1] - __builtin_bit_cast(float, w0 & 0xffff0000u)) * 4096.f + 128.5f;
                        const float l2 = (y[2] - __builtin_bit_cast(float, w1 << 16)) * 4096.f + 128.5f, l3 = (y[3] - __builtin_bit_cast(float, w1 & 0xffff0000u)) * 4096.f + 128.5f;
                        const unsigned q = (unsigned)(int)fminf(fmaxf(l0, 0.f), 255.f) | ((unsigned)(int)fminf(fmaxf(l1, 0.f), 255.f) << 8) | ((unsigned)(int)fminf(fmaxf(l2, 0.f), 255.f) << 16) | ((unsigned)(int)fminf(fmaxf(l3, 0.f), 255.f) << 24);
                        if (n == 0) { wv.x = w0; wv.y = w1; } else { wv.z = w0; wv.w = w1; }
                        if (bj == 0) { if (n == 0) qv.x = q; else qv.y = q; } else { if (n == 0) qv.z = q; else qv.w = q; } }
                    *(u32x4*)(hb + off + bj * HALF) = wv; }
                *(u32x4*)(lob + (off - col0) + lo0) = qv;
                __builtin_amdgcn_sched_barrier(0); }
        }
    }
};

template <class Epi, class Sched, bool ALIGN_EPI = true>
__device__ __forceinline__ void gemm_phase(LAS unsigned char* lds, const Gemm g, const Sched& S, const Epi& E) {
    int tid = threadIdx.x; asm volatile("" : "+v"(tid));
    const int wid = __builtin_amdgcn_readfirstlane(tid >> 6), lane = tid & 63, wr = wid >> 2, wc = wid & 3, fr = lane & 15, fq = lane >> 4;
    const int K = g.K, nt = K / BK;
    unsigned voffA[2], voffB[2];
#pragma unroll
    for (int i = 0; i < 2; ++i) { int R, C; stage_rc(tid * 16 + i * 8192, R, C); const int Rb = Epi::PERM ? ((R & ~31) + perm32(R & 31)) : R;
        voffA[i] = (unsigned)(R * K + C) * 2u; voffB[i] = (unsigned)(Rb * K + C) * 2u; }
    const size_t kstep = (size_t)(BK * 2);
    const size_t hstep = (size_t)HALF * K * 2;
    const size_t tstep = 2 * hstep;
    const unsigned ldsw = (unsigned)wid * 1024u;
    const int aoff = lds_byte(wr * 64 + fr, fq * 8), boff = lds_byte(wc * 32 + fr, fq * 8);
#define PG8_SA(b, h) (((b) * 2 + (h)) * HTB)
#define PG8_SB(b, h) ((4 + (b) * 2 + (h)) * HTB)
#define PG8_STAGE(bufoff, gbase, voff) do { _Pragma("unroll") for (int _i = 0; _i < 2; ++_i) \
        __builtin_amdgcn_global_load_lds((const unsigned*)((const char*)(gbase) + (voff)[_i]), (LAS unsigned*)(lds + (bufoff) + ldsw + _i * 8192), 16, 0, 0); } while (0)
#define PG8_LDA(dst, b, h) do { _Pragma("unroll") for (int m = 0; m < 4; ++m) _Pragma("unroll") for (int k = 0; k < 2; ++k) dst[m][k] = *(const LAS bf16x8*)(lds + PG8_SA(b, h) + aoff + m * 2048 + k * 1024); } while (0)
#define PG8_LDB(dst, b, h) do { _Pragma("unroll") for (int n = 0; n < 2; ++n) _Pragma("unroll") for (int k = 0; k < 2; ++k) dst[n][k] = *(const LAS bf16x8*)(lds + PG8_SB(b, h) + boff + n * 2048 + k * 1024); } while (0)
#define PG8_MMA(ai, bj, At, Bt) do { __builtin_amdgcn_s_setprio(1); _Pragma("unroll") for (int m = 0; m < 4; ++m) _Pragma("unroll") for (int n = 0; n < 2; ++n) _Pragma("unroll") for (int k = 0; k < 2; ++k) \
        acc[ai][bj][m][n] = __builtin_amdgcn_mfma_f32_16x16x32_bf16(Bt[n][k], At[m][k], acc[ai][bj][m][n], 0, 0, 0); __builtin_amdgcn_s_setprio(0); } while (0)
#define PG8_WAIT_V(n) asm volatile("s_waitcnt vmcnt(" #n ")" ::: "memory")
#define PG8_WAIT_L(n) asm volatile("s_waitcnt lgkmcnt(" #n ")" ::: "memory")
#define PG8_BAR __builtin_amdgcn_s_barrier()
#define PG8_SCHED __builtin_amdgcn_sched_barrier(0)
    Unit cur, nxt; int ui = 0;
    if (!S.next(0, cur)) return;
    f32x4 acc[2][2][4][2];
#pragma unroll
    for (int a = 0; a < 2; ++a)
#pragma unroll
        for (int b = 0; b < 2; ++b)
#pragma unroll
            for (int m = 0; m < 4; ++m)
#pragma unroll
                for (int n = 0; n < 2; ++n) acc[a][b][m][n] = (f32x4){0.f, 0.f, 0.f, 0.f};
    bf16x8 At[4][2], B0[2][2], B1[2][2];
    const char* cA = (const char*)g.A + (size_t)cur.pm * tstep; const char* cB = (const char*)g.Bt + (size_t)cur.pn * tstep;
    PG8_STAGE(PG8_SB(0, 0), cB, voffB); PG8_STAGE(PG8_SB(0, 1), cB + hstep, voffB); PG8_STAGE(PG8_SA(0, 0), cA, voffA); PG8_STAGE(PG8_SA(0, 1), cA + hstep, voffA);
    if (wr == 1) PG8_BAR;
    PG8_WAIT_V(2); PG8_BAR;
    PG8_STAGE(PG8_SB(1, 0), cB + kstep, voffB); PG8_STAGE(PG8_SA(1, 0), cA + kstep, voffA); PG8_STAGE(PG8_SB(1, 1), cB + hstep + kstep, voffB);
    PG8_WAIT_V(6); PG8_BAR;
    for (;;) {
        const bool has_next = S.next(ui + 1, nxt);
        const char* nA = has_next ? (const char*)g.A + (size_t)nxt.pm * tstep : cA; const char* nB = has_next ? (const char*)g.Bt + (size_t)nxt.pn * tstep : cB;
        for (int t = 0; t < nt; t += 2) {
            const bool last = (t == nt - 2);
            const char* a1 = cA + (size_t)(t + 1) * kstep;
            const char* a2 = last ? nA : cA + (size_t)(t + 2) * kstep; const char* b2 = last ? nB : cB + (size_t)(t + 2) * kstep;
            const char* a3 = a2 + kstep; const char* b3 = b2 + kstep;
            PG8_LDB(B0, 0, 0); PG8_LDB(B1, 0, 1); PG8_SCHED; PG8_LDA(At, 0, 0); PG8_STAGE(PG8_SA(1, 1), a1 + hstep, voffA);
            PG8_WAIT_V(8); PG8_WAIT_L(0); PG8_BAR; PG8_MMA(0, 0, At, B0); PG8_MMA(0, 1, At, B1); PG8_BAR; PG8_SCHED;
            PG8_LDA(At, 0, 1); PG8_STAGE(PG8_SB(0, 0), b2, voffB); PG8_STAGE(PG8_SB(0, 1), b2 + hstep, voffB); PG8_STAGE(PG8_SA(0, 0), a2, voffA);
            PG8_WAIT_V(8); PG8_WAIT_L(0); PG8_BAR; PG8_MMA(1, 0, At, B0); PG8_MMA(1, 1, At, B1); PG8_BAR; PG8_SCHED;
            PG8_LDB(B0, 1, 0); PG8_LDB(B1, 1, 1); PG8_SCHED; PG8_LDA(At, 1, 0); PG8_STAGE(PG8_SA(0, 1), a2 + hstep, voffA);
            PG8_WAIT_V(8); PG8_WAIT_L(0); PG8_BAR; PG8_MMA(0, 0, At, B0); PG8_MMA(0, 1, At, B1); PG8_BAR; PG8_SCHED;
            PG8_LDA(At, 1, 1); PG8_STAGE(PG8_SB(1, 0), b3, voffB); PG8_STAGE(PG8_SB(1, 1), b3 + hstep, voffB); PG8_STAGE(PG8_SA(1, 0), a3, voffA);
            PG8_WAIT_V(8); PG8_WAIT_L(0); PG8_BAR; PG8_MMA(1, 0, At, B0); PG8_MMA(1, 1, At, B1); PG8_BAR; PG8_SCHED;
        }
        if constexpr (ALIGN_EPI) { if (wr == 0) PG8_BAR; }
        E(acc, cur, wr, wc, fr, fq);
        if (!has_next) break;
#pragma unroll
        for (int a = 0; a < 2; ++a)
#pragma unroll
            for (int b = 0; b < 2; ++b)
#pragma unroll
                for (int m = 0; m < 4; ++m)
#pragma unroll
                    for (int n = 0; n < 2; ++n) acc[a][b][m][n] = (f32x4){0.f, 0.f, 0.f, 0.f};
        cur = nxt; cA = nA; cB = nB; ++ui;
        if constexpr (ALIGN_EPI) { if (wr == 1) PG8_BAR; }
    }
    PG8_WAIT_V(0);
    if constexpr (!ALIGN_EPI) { if (wr == 0) PG8_BAR; }
    PG8_BAR;
#undef PG8_SA
#undef PG8_SB
#undef PG8_STAGE
#undef PG8_LDA
#undef PG8_LDB
#undef PG8_MMA
#undef PG8_WAIT_V
#undef PG8_WAIT_L
#undef PG8_BAR
#undef PG8_SCHED
}
}

namespace att {
constexpr int KROW = 144, KBUF = 64 * KROW;
constexpr int OFF_K = 0, OFF_V = 4 * KBUF, OFF_C = 8 * KBUF, OFF_LUT = OFF_C + SEQ * 4, LUT_N = 320, OFF_FLAG = OFF_LUT + LUT_N * 4;
constexpr int OFF_LUT_SWA = 12 * KBUF;
constexpr float DEAD = -136.f;
enum { M_SB = 0, M_SWA = 1, M_FOX = 2 };

__device__ __forceinline__ float other_half(float x, int hi) {
    const unsigned u = __float_as_uint(x); auto rr = __builtin_amdgcn_permlane32_swap(u, u, false, false);
    return __uint_as_float(hi ? rr[0] : rr[1]);
}
__device__ __forceinline__ f32x16 mfma32(bf16x8 a, bf16x8 b, f32x16 c) { return __builtin_amdgcn_mfma_f32_32x32x16_bf16(a, b, c, 0, 0, 0); }

__device__ __forceinline__ void pv_block(f32x16 (&o)[2], const f32x16& p, const LAS unsigned char* vb) {
#pragma unroll
    for (int j = 0; j < 2; ++j) {
        u32x4 pw; pw.x = cvt_pk(p[8 * j + 0], p[8 * j + 1]); pw.y = cvt_pk(p[8 * j + 2], p[8 * j + 3]); pw.z = cvt_pk(p[8 * j + 4], p[8 * j + 5]); pw.w = cvt_pk(p[8 * j + 6], p[8 * j + 7]);
        const bf16x8 pf = __builtin_bit_cast(bf16x8, pw);
#pragma unroll
        for (int db = 0; db < 2; ++db) { const bf16x8 vf = *(const LAS bf16x8*)(vb + db * 32 * KROW + j * 16); o[db] = mfma32(vf, pf, o[db]); }
    }
}
template <bool DIAG>
__device__ __forceinline__ void sb_block_t(f32x16& s, float& carry, int keybase, int tpos, int hi) {
    float tot = 0.f;
#pragma unroll
    for (int r = 15; r >= 0; --r) {
        const float z = s[r]; const float e = ex2(-z); const float L = lg2(1.f + e);
        const bool valid = !DIAG || (keybase + r < tpos);
        const float lsn = valid ? -(L + z) : 0.f;
        const float a = tot; tot += lsn; s[r] = valid ? (a - L) : -INFINITY;
    }
    const float other = other_half(tot, hi);
    const float base = carry + (hi ? 0.f : other);
#pragma unroll
    for (int r = 0; r < 16; ++r) s[r] = ex2(s[r] + base);
    carry += tot + other;
}
__device__ __forceinline__ void sb_block(f32x16& s, float& carry, int keybase, int tpos, bool diag, int hi) {
    if (diag) { asm volatile("" ::: "memory"); sb_block_t<true>(s, carry, keybase, tpos, hi); }
    else sb_block_t<false>(s, carry, keybase, tpos, hi);
}
__device__ __forceinline__ void sm_tile(f32x16& s0, f32x16& s1, f32x16 (&o)[2], float& m, float& l) {
    float t = fmaxf(s0[0], s1[0]);
#pragma unroll
    for (int r = 1; r < 16; ++r) t = fmaxf(t, fmaxf(s0[r], s1[r]));
    { const unsigned u = __float_as_uint(t); auto rr = __builtin_amdgcn_permlane32_swap(u, u, false, false); t = fmaxf(__uint_as_float(rr[0]), __uint_as_float(rr[1])); }
    const float mn = fmaxf(m, t); const float alpha = ex2(m - mn); m = mn; l *= alpha;
    if (__any(alpha != 1.f)) { o[0] *= alpha; o[1] *= alpha; }
    float sum = 0.f;
#pragma unroll
    for (int r = 0; r < 16; ++r) { s0[r] = ex2(s0[r] - mn); s1[r] = ex2(s1[r] - mn); sum += s0[r] + s1[r]; }
    l += sum;
}

template <int MODE>
__device__ __forceinline__ void attn_unit(LAS unsigned char* lds, const bf16_t* QKV, int ld, int qcol, int kcol, int vcol, bf16_t* OB, int ocol, int b, int qb, float sinkv, float kmax) {
    int tid = threadIdx.x; asm volatile("" : "+v"(tid));
    const int lane = tid & 63, w = __builtin_amdgcn_readfirstlane(tid >> 6), q32 = lane & 31, hi = lane >> 5;
    const int q0 = qb * 256, qw0 = q0 + 32 * w, tpos = qw0 + q32;
    const size_t rowb = (size_t)b * SEQ;
    bf16x8 qf[4];
    { const bf16_t* qp = QKV + (rowb + tpos) * ld + qcol + 8 * hi;
#pragma unroll
      for (int c = 0; c < 4; ++c) qf[c] = *(const bf16x8*)(qp + 16 * c); }
    const int skey = tid >> 3, sch = tid & 7;
    const bf16_t* kg = QKV + (rowb + skey) * ld + kcol + 8 * sch;
    const bf16_t* vg = QKV + (rowb + skey) * ld + vcol + 8 * sch;
    LAS unsigned char* Kb = lds + OFF_K; LAS unsigned char* Vb = lds + (MODE == M_SWA ? 6 * KBUF : OFF_V);
    const LAS float* carr = (const LAS float*)(lds + OFF_C); const LAS float* lut = (const LAS float*)(lds + OFF_LUT_SWA);
    const int kwr = skey * KROW + sch * 16, vwr = (8 * sch) * KROW + skey * 2;
    const int kperm = 16 * ((q32 >> 2) & 1) + 4 * (q32 >> 3) + (q32 & 3);
    const int krd = kperm * KROW + hi * 16, vrd = q32 * KROW + hi * 32;
    const int kt_hi = 4 * qb + 3, kt_lo = (MODE == M_SWA) ? (4 * qb - 2 > 0 ? 4 * qb - 2 : 0) : 0;

#define ATT_LOAD(KR, VR, t) do { KR = *(const u32x4*)(kg + (size_t)(t) * 64 * ld); VR = *(const u32x4*)(vg + (size_t)(t) * 64 * ld); } while (0)
    u32x4 kA, vA, kB, vB;
    if (MODE != M_SWA) { ATT_LOAD(kA, vA, kt_hi); ATT_LOAD(kB, vB, kt_hi - 1); }
    f32x16 o[2]; o[0] = (f32x16)(0.f); o[1] = (f32x16)(0.f);
    float carry = 0.f, m = (MODE == M_SWA) ? sinkv : -INFINITY, l = (MODE == M_SWA && hi == 0) ? 1.f : 0.f;
    float ct = 0.f, zb = 0.f;
    if (MODE == M_FOX) {
        float qq = 0.f;
#pragma unroll
        for (int c = 0; c < 4; ++c)
#pragma unroll
            for (int e = 0; e < 8; ++e) { const float x = __builtin_bit_cast(float, (unsigned)(unsigned short)qf[c][e] << 16); qq += x * x; }
        qq += __shfl_xor(qq, 32);
        zb = sqrtf(qq) * kmax * 1.002f + 0.01f; }
    volatile LAS unsigned* flag = (volatile LAS unsigned*)(lds + OFF_FLAG);
    if (MODE != M_SWA && tid == 0) { flag[0] = 0u; flag[1] = 0u; }
    bool wdead = false; unsigned dw0 = 0u, dw1 = 0u;

#define ATT_WRITE(buf, KR, VR) do { *(LAS u32x4*)(Kb + (buf) * KBUF + kwr) = KR; LAS unsigned short* vp_ = (LAS unsigned short*)(Vb + (buf) * KBUF + vwr); \
        vp_[0 * (KROW / 2)] = (unsigned short)(VR.x & 0xffffu); vp_[1 * (KROW / 2)] = (unsigned short)(VR.x >> 16); vp_[2 * (KROW / 2)] = (unsigned short)(VR.y & 0xffffu); vp_[3 * (KROW / 2)] = (unsigned short)(VR.y >> 16); \
        vp_[4 * (KROW / 2)] = (unsigned short)(VR.z & 0xffffu); vp_[5 * (KROW / 2)] = (unsigned short)(VR.z >> 16); vp_[6 * (KROW / 2)] = (unsigned short)(VR.w & 0xffffu); vp_[7 * (KROW / 2)] = (unsigned short)(VR.w >> 16); } while (0)
#define ATT_COMPUTE(kt_, cur_, par_) do { \
        const int k0 = (kt_) * 64; \
        bool active, diag; \
        if (MODE == M_SB) { active = k0 <= qw0 + 30; diag = k0 + 63 >= qw0; } \
        else if (MODE == M_FOX) { active = k0 <= qw0 + 31; diag = k0 + 63 > qw0; } \
        else { active = (k0 <= qw0 + 31) && (k0 + 63 >= qw0 - 127); diag = true; } \
        if (MODE == M_FOX && active && !wdead && !diag) { \
              \
            const float dmax = carr[k0 + 63];            \
            if (__all(dmax + zb - m <= DEAD)) { wdead = true; if (lane == 0) __hip_atomic_fetch_add((LAS unsigned*)(lds + OFF_FLAG) + (par_), 1u, __ATOMIC_RELAXED, __HIP_MEMORY_SCOPE_WORKGROUP); } \
        } \
        if (active && !wdead) { \
            const LAS unsigned char* kb_ = Kb + (cur_) * KBUF + krd; const LAS unsigned char* vb_ = Vb + (cur_) * KBUF + vrd; \
            f32x16 s0, s1; \
            if (MODE == M_FOX) { \
                  \
                const LAS f32x4* c0 = (const LAS f32x4*)(carr + k0 + 16 * hi); const LAS f32x4* c1 = (const LAS f32x4*)(carr + k0 + 32 + 16 * hi); \
                _Pragma("unroll") for (int i = 0; i < 4; ++i) { const f32x4 a = c0[i], bq = c1[i]; \
                    _Pragma("unroll") for (int j = 0; j < 4; ++j) { s0[4 * i + j] = a[j]; s1[4 * i + j] = bq[j]; } } \
            } else { s0 = (f32x16)(0.f); s1 = (f32x16)(0.f); } \
            _Pragma("unroll") for (int c = 0; c < 4; ++c) { \
                const bf16x8 k0f = *(const LAS bf16x8*)(kb_ + c * 32); const bf16x8 k1f = *(const LAS bf16x8*)(kb_ + 32 * KROW + c * 32); \
                s0 = mfma32(k0f, qf[c], s0); s1 = mfma32(k1f, qf[c], s1); } \
            const int kbase0 = k0 + 16 * hi, kbase1 = k0 + 32 + 16 * hi; \
            if (MODE == M_SB) { \
                sb_block(s1, carry, kbase1, tpos, diag, hi); \
                pv_block(o, s1, vb_ + 64); \
                sb_block(s0, carry, kbase0, tpos, diag, hi); \
                pv_block(o, s0, vb_); \
                  \
                if (__all(carry <= DEAD)) { wdead = true; if (lane == 0) __hip_atomic_fetch_add((LAS unsigned*)(lds + OFF_FLAG) + (par_), 1u, __ATOMIC_RELAXED, __HIP_MEMORY_SCOPE_WORKGROUP); } \
            } else { \
                if (MODE == M_SWA) { \
                    const LAS float* l0 = lut + (tpos - kbase0 + 64 - 15); const LAS float* l1 = lut + (tpos - kbase1 + 64 - 15); \
                    _Pragma("unroll") for (int r = 0; r < 16; ++r) { \
                        const int rel0 = tpos - (kbase0 + r), rel1 = tpos - (kbase1 + r); \
                        s0[r] = (rel0 >= 0 && rel0 < 128) ? s0[r] + l0[15 - r] : -INFINITY; \
                        s1[r] = (rel1 >= 0 && rel1 < 128) ? s1[r] + l1[15 - r] : -INFINITY; } \
                } else if (diag) { asm volatile("" ::: "memory");        \
                    _Pragma("unroll") for (int r = 0; r < 16; ++r) { if (kbase0 + r > tpos) s0[r] = -INFINITY; if (kbase1 + r > tpos) s1[r] = -INFINITY; } \
                } \
                sm_tile(s0, s1, o, m, l); \
                pv_block(o, s1, vb_ + 64); \
                pv_block(o, s0, vb_); \
            } \
        } } while (0)

#define ATT_COMPUTE2(kt_, sa_, sb_, par_) do { \
        const int k0a = (kt_) * 64, k0b = k0a - 64; \
        const bool diagA = (MODE == M_SB) ? (k0a + 63 >= qw0) : (k0a + 63 > qw0), diagB = (MODE == M_SB) ? (k0b + 63 >= qw0) : (k0b + 63 > qw0); \
        const bool fast = (MODE != M_SWA) && !wdead && (k0a <= qw0 + (MODE == M_SB ? 30 : 31));        \
        if (fast && MODE == M_FOX && !diagA) { \
            const float dmax = carr[k0a + 63]; \
            if (__all(dmax + zb - m <= DEAD)) { wdead = true; if (lane == 0) __hip_atomic_fetch_add((LAS unsigned*)(lds + OFF_FLAG) + (par_), 1u, __ATOMIC_RELAXED, __HIP_MEMORY_SCOPE_WORKGROUP); } \
        } \
        if (fast) { if (!wdead) { \
            const LAS unsigned char* kba = Kb + (sa_) * KBUF + krd; const LAS unsigned char* vba = Vb + (sa_) * KBUF + vrd; \
            const LAS unsigned char* kbb = Kb + (sb_) * KBUF + krd; const LAS unsigned char* vbb = Vb + (sb_) * KBUF + vrd; \
            f32x16 a0, a1, b0, b1; \
            if (MODE == M_FOX) { \
                const LAS f32x4* c0 = (const LAS f32x4*)(carr + k0a + 16 * hi); const LAS f32x4* c1 = (const LAS f32x4*)(carr + k0a + 32 + 16 * hi); \
                const LAS f32x4* d0 = (const LAS f32x4*)(carr + k0b + 16 * hi); const LAS f32x4* d1 = (const LAS f32x4*)(carr + k0b + 32 + 16 * hi); \
                _Pragma("unroll") for (int i = 0; i < 4; ++i) { const f32x4 x0 = c0[i], x1 = c1[i], y0 = d0[i], y1 = d1[i]; \
                    _Pragma("unroll") for (int j = 0; j < 4; ++j) { a0[4 * i + j] = x0[j]; a1[4 * i + j] = x1[j]; b0[4 * i + j] = y0[j]; b1[4 * i + j] = y1[j]; } } \
            } else { a0 = (f32x16)(0.f); a1 = (f32x16)(0.f); b0 = (f32x16)(0.f); b1 = (f32x16)(0.f); } \
            _Pragma("unroll") for (int c = 0; c < 4; ++c) { \
                const bf16x8 ka0 = *(const LAS bf16x8*)(kba + c * 32); const bf16x8 ka1 = *(const LAS bf16x8*)(kba + 32 * KROW + c * 32); \
                a0 = mfma32(ka0, qf[c], a0); a1 = mfma32(ka1, qf[c], a1); } \
            _Pragma("unroll") for (int c = 0; c < 4; ++c) { \
                const bf16x8 kb0 = *(const LAS bf16x8*)(kbb + c * 32); const bf16x8 kb1 = *(const LAS bf16x8*)(kbb + 32 * KROW + c * 32); \
                b0 = mfma32(kb0, qf[c], b0); b1 = mfma32(kb1, qf[c], b1); } \
            if (MODE == M_SB) { \
                sb_block(a1, carry, k0a + 32 + 16 * hi, tpos, diagA, hi); pv_block(o, a1, vba + 64); \
                sb_block(a0, carry, k0a + 16 * hi, tpos, diagA, hi); pv_block(o, a0, vba); \
                if (__all(carry <= DEAD)) { wdead = true; if (lane == 0) __hip_atomic_fetch_add((LAS unsigned*)(lds + OFF_FLAG) + (par_), 1u, __ATOMIC_RELAXED, __HIP_MEMORY_SCOPE_WORKGROUP); } \
                else { \
                    sb_block(b1, carry, k0b + 32 + 16 * hi, tpos, diagB, hi); pv_block(o, b1, vbb + 64); \
                    sb_block(b0, carry, k0b + 16 * hi, tpos, diagB, hi); pv_block(o, b0, vbb); \
                    if (__all(carry <= DEAD)) { wdead = true; if (lane == 0) __hip_atomic_fetch_add((LAS unsigned*)(lds + OFF_FLAG) + (par_), 1u, __ATOMIC_RELAXED, __HIP_MEMORY_SCOPE_WORKGROUP); } \
                } \
            } else { \
                if (diagA) { asm volatile("" ::: "memory"); const int ka0_ = k0a + 16 * hi, ka1_ = k0a + 32 + 16 * hi; \
                    _Pragma("unroll") for (int r = 0; r < 16; ++r) { if (ka0_ + r > tpos) a0[r] = -INFINITY; if (ka1_ + r > tpos) a1[r] = -INFINITY; } } \
                sm_tile(a0, a1, o, m, l); pv_block(o, a1, vba + 64); pv_block(o, a0, vba); \
                const float dmaxb = carr[k0b + 63]; \
                if (MODE == M_FOX && !diagB && __all(dmaxb + zb - m <= DEAD)) { wdead = true; if (lane == 0) __hip_atomic_fetch_add((LAS unsigned*)(lds + OFF_FLAG) + (par_), 1u, __ATOMIC_RELAXED, __HIP_MEMORY_SCOPE_WORKGROUP); } \
                else { \
                    if (diagB) { asm volatile("" ::: "memory"); const int kb0_ = k0b + 16 * hi, kb1_ = k0b + 32 + 16 * hi; \
                        _Pragma("unroll") for (int r = 0; r < 16; ++r) { if (kb0_ + r > tpos) b0[r] = -INFINITY; if (kb1_ + r > tpos) b1[r] = -INFINITY; } } \
                    sm_tile(b0, b1, o, m, l); pv_block(o, b1, vbb + 64); pv_block(o, b0, vbb); } \
            } \
        } } else { ATT_COMPUTE(kt_, sa_, par_); ATT_COMPUTE((kt_) - 1, sb_, par_); } \
    } while (0)

    if (MODE == M_SWA) {
        const int nt = kt_hi - kt_lo + 1;
        u32x4 kr[6], vr[6];
#pragma unroll
        for (int t = 0; t < 6; ++t) if (t < nt) ATT_LOAD(kr[t], vr[t], kt_lo + t);
#pragma unroll
        for (int t = 0; t < 6; ++t) if (t < nt) ATT_WRITE(t, kr[t], vr[t]);
        __syncthreads();
        for (int kt = kt_hi; kt >= kt_lo; --kt) { const int slot = kt - kt_lo; ATT_COMPUTE(kt, slot, 0); }
        __syncthreads();
    } else {
        ATT_WRITE(0, kA, vA); ATT_WRITE(1, kB, vB);
        ATT_LOAD(kA, vA, kt_hi - 2); ATT_LOAD(kB, vB, kt_hi - 3);
        __syncthreads();
        int kt = kt_hi;
        for (;;) {
            if (kt - 2 >= kt_lo) { ATT_WRITE(2, kA, vA); ATT_WRITE(3, kB, vB); if (kt - 4 >= kt_lo) { ATT_LOAD(kA, vA, kt - 4); ATT_LOAD(kB, vB, kt - 5); } }
            ATT_COMPUTE2(kt, 0, 1, 0);
            __syncthreads();
            dw0 = flag[0];
            if (dw0 + dw1 >= 8u) break;
            kt -= 2; if (kt < kt_lo) break;
            if (kt - 2 >= kt_lo) { ATT_WRITE(0, kA, vA); ATT_WRITE(1, kB, vB); if (kt - 4 >= kt_lo) { ATT_LOAD(kA, vA, kt - 4); ATT_LOAD(kB, vB, kt - 5); } }
            ATT_COMPUTE2(kt, 2, 3, 1);
            __syncthreads();
            dw1 = flag[1];
            if (dw0 + dw1 >= 8u) break;
            kt -= 2; if (kt < kt_lo) break;
        }
        __syncthreads();
    }
#undef ATT_LOAD
#undef ATT_WRITE
#undef ATT_COMPUTE
#undef ATT_COMPUTE2
    float inv = 1.f;
    if (MODE != M_SB) { const float lt = l + __shfl_xor(l, 32); inv = 1.f / lt; }
    {
        LAS unsigned char* stg = lds + w * (32 * KROW);
#pragma unroll
        for (int db = 0; db < 2; ++db)
#pragma unroll
            for (int a = 0; a < 4; ++a) { u32x2 wv; wv.x = cvt_pk(o[db][4 * a] * inv, o[db][4 * a + 1] * inv); wv.y = cvt_pk(o[db][4 * a + 2] * inv, o[db][4 * a + 3] * inv);
                *(LAS u32x2*)(stg + q32 * KROW + (32 * db + 8 * a + 4 * hi) * 2) = wv; }
        asm volatile("s_waitcnt lgkmcnt(0)" ::: "memory");
        bf16_t* ob = OB + (rowb + qw0) * D_MODEL + ocol;
#pragma unroll
        for (int i = 0; i < 4; ++i) { const int row = i * 8 + (lane >> 3), ch = lane & 7; const u32x4 v = *(const LAS u32x4*)(stg + row * KROW + ch * 16); *(u32x4*)(ob + (size_t)row * D_MODEL + ch * 8) = v; }
        __syncthreads();
    }
}

__device__ __forceinline__ int t5_bucket(int n) {
    if (n < 16) return n;
    int v = 16 + (int)(logf((float)n / 16.f) / 2.0794415416798357f * 16.f);
    return v < 31 ? v : 31;
}
}

constexpr size_t MiB = 1u << 20;
constexpr size_t WS_FFN_IN = 0, WS_FFN_OUT = 44 * MiB, WS_AB_IN = 66 * MiB, WS_AB_OUT = 70 * MiB + MiB / 2, WS_FOX_IN = 72 * MiB + MiB / 2, WS_FOX_OUT = 79 * MiB;
constexpr size_t WS_HB = 96 * MiB, WS_BIG = 160 * MiB, WS_OB = 352 * MiB, WS_F = 416 * MiB, WS_CTL = 419 * MiB, WS_XBUF = 420 * MiB, WS_LO = 421 * MiB, WS_END = 453 * MiB;
constexpr int CNT_OFF = 4096, CNT_WORDS = 6 * 128 * 64;
constexpr int LDS_X_OFF = 131072 + 1024;
constexpr int LDS_ST_OFF = 131072 + 320;
constexpr size_t FFN_IN_BYTES = 11 * MiB, FFN_OUT_BYTES = 5 * MiB + MiB / 2;
constexpr int LDS_BYTES = 147456;
constexpr int N_PHASES = 15;


#define XB_TMO      128
#define XB_XCNT(j)  (256  + 64 * (j))
#define XB_XSUB(j)  (1280 + 64 * (j))
#define XB_XGEN(j)  (2304 + 64 * (j))
#define XB_TOP      3328
#define XB_TOPGEN   3392
#define XCD_BAR_WORDS 3456
#define XB_SPIN_CAP (1u << 18)
__device__ __forceinline__ unsigned xb_ld(unsigned* p)              { return __hip_atomic_load(p, __ATOMIC_RELAXED, __HIP_MEMORY_SCOPE_AGENT); }
__device__ __forceinline__ unsigned xb_add(unsigned* p, unsigned v) { return __hip_atomic_fetch_add(p, v, __ATOMIC_RELAXED, __HIP_MEMORY_SCOPE_AGENT); }
__device__ __forceinline__ unsigned xb_xcc_id() { return (unsigned)__builtin_amdgcn_s_getreg((3 << 11) | 20) & 0xFu; }
#define XB_SPIN(cond, bar) do { unsigned _sp = 0; while (cond) { __builtin_amdgcn_s_sleep(1); \
    if ((++_sp & 255u) == 0u) { if (xb_ld(&(bar)[XB_TMO])) break; if (_sp > XB_SPIN_CAP) { atomicAdd(&(bar)[XB_TMO], 1u); break; } } } } while (0)
__device__ __forceinline__ void xcd_barrier_complete(unsigned* bar, unsigned x, unsigned& nloc, unsigned& nx) {
    const unsigned G = gridDim.x;
    unsigned sum, cnt, mine, sp = 0u;
    for (;;) {
        sum = 0u; cnt = 0u; mine = 0u;
#pragma unroll
        for (unsigned j = 0; j < 16; ++j) { const unsigned c = xb_ld(&bar[XB_XCNT(j)]); sum += c; cnt += (c > 0u) ? 1u : 0u; mine = (j == x) ? c : mine; }
        if (sum == G) break;
        __builtin_amdgcn_s_sleep(1);
        if ((++sp & 255u) == 0u) { if (xb_ld(&bar[XB_TMO])) break; if (sp > XB_SPIN_CAP) { atomicAdd(&bar[XB_TMO], 1u); break; } }
    }
    nloc = mine > 0u ? mine : 1u; nx = cnt > 0u ? cnt : 1u;
}
__device__ __forceinline__ void xcd_barrier(unsigned* bar, volatile LAS unsigned* st) {
    asm volatile("s_waitcnt vmcnt(0)" ::: "memory");
    __syncthreads();
    if (threadIdx.x == 0) {
        const unsigned x = xb_xcc_id();
        __builtin_amdgcn_s_waitcnt(0);
        unsigned nloc = st[0], nx = st[1];
        if (nloc == 0u) { xcd_barrier_complete(bar, x, nloc, nx); st[0] = nloc; st[1] = nx; }
        const unsigned old = xb_add(&bar[XB_XSUB(x)], 1u);
        const unsigned gen = old / nloc;
        if (old + 1u == (gen + 1u) * nloc) {
            __builtin_amdgcn_fence(__ATOMIC_RELEASE, "agent");
            asm volatile("s_waitcnt vmcnt(0)" ::: "memory");
            const unsigned og = xb_add(&bar[XB_TOP], 1u);
            const unsigned tg = og / nx;
            if (og + 1u == (tg + 1u) * nx) xb_add(&bar[XB_TOPGEN], 1u);
            else XB_SPIN(xb_ld(&bar[XB_TOPGEN]) == tg, bar);
            __builtin_amdgcn_fence(__ATOMIC_ACQUIRE, "agent");
            xb_add(&bar[XB_XGEN(x)], 1u);
            asm volatile("s_waitcnt vmcnt(0)" ::: "memory");
        } else {
            XB_SPIN(xb_ld(&bar[XB_XGEN(x)]) == gen, bar);
            __builtin_amdgcn_fence(__ATOMIC_ACQUIRE, "agent");
            asm volatile("s_waitcnt vmcnt(0)" ::: "memory");
        }
    }
    __syncthreads();
}

struct Args { const float* in[14]; float* out; unsigned char* ws; int ph_lo, ph_hi; };

__device__ __forceinline__ float wave_sum(float v) {
#pragma unroll
    for (int o = 1; o < 64; o <<= 1) v += __shfl_xor(v, o);
    return v;
}
__device__ __forceinline__ unsigned f2bf(float f) { unsigned u = __builtin_bit_cast(unsigned, f); return (u + 0x7fffu + ((u >> 16) & 1u)) >> 16; }
__device__ __forceinline__ unsigned pk2(float lo, float hi) { return f2bf(lo) | (f2bf(hi) << 16); }

__device__ __forceinline__ void transpose_item(const float* W, int ldw, int K, bf16_t* WT, int k0, int n0, int drow0, LAS float* scr, int lane) {
#pragma unroll
    for (int i = 0; i < 8; ++i) { const int idx = lane + 64 * i, kk = idx >> 3, c4 = idx & 7; const f32x4 v = *(const f32x4*)(W + (size_t)(k0 + kk) * ldw + n0 + 4 * c4);
        LAS float* d = scr + kk * 33 + 4 * c4; d[0] = v[0]; d[1] = v[1]; d[2] = v[2]; d[3] = v[3]; }
    asm volatile("s_waitcnt lgkmcnt(0)" ::: "memory");
    const int c = lane & 7;
#pragma unroll
    for (int j = 0; j < 4; ++j) { const int n = (lane >> 3) + 8 * j; const LAS float* s = scr + (8 * c) * 33 + n;
        u32x4 o; o.x = pk2(s[0 * 33], s[1 * 33]); o.y = pk2(s[2 * 33], s[3 * 33]); o.z = pk2(s[4 * 33], s[5 * 33]); o.w = pk2(s[6 * 33], s[7 * 33]);
        *(u32x4*)(WT + (size_t)(drow0 + n) * K + k0 + 8 * c) = o; }
    asm volatile("s_waitcnt lgkmcnt(0)" ::: "memory");
}

__global__ void __launch_bounds__(512, 2) mega(Args args) {
    extern __shared__ __attribute__((aligned(16))) unsigned char lds_raw[];
    LAS unsigned char* lds = (LAS unsigned char*)lds_raw;
    cg::grid_group grid = cg::this_grid();
    typedef const __attribute__((address_space(4))) Args* kargp_t;
    if (threadIdx.x < 2) ((volatile LAS unsigned*)(lds + LDS_ST_OFF))[threadIdx.x] = 0u;
    __syncthreads();

    for (int pp = args.ph_lo; pp < args.ph_hi; ++pp) {
        const int p = pp;
        int tid = threadIdx.x; asm volatile("" : "+v"(tid));
        int bid = blockIdx.x; asm volatile("" : "+s"(bid));
        int G = gridDim.x; asm volatile("" : "+s"(G));
        const int lane = tid & 63, wave = __builtin_amdgcn_readfirstlane(tid >> 6);
        const int gw = bid * 8 + wave, NGW = G * 8;
        kargp_t ap = (kargp_t)__builtin_amdgcn_kernarg_segment_ptr(); asm volatile("" : "+s"(ap));
        unsigned char* ws = ap->ws;
        bf16_t* HB = (bf16_t*)(ws + WS_HB); bf16_t* BIG = (bf16_t*)(ws + WS_BIG); bf16_t* OB = (bf16_t*)(ws + WS_OB); float* FB = (float*)(ws + WS_F);
        float* out = ap->out;
        if (EN_P0 && p == 0) {
            LAS float* scr = (LAS float*)(lds + wave * 16384);
            constexpr int I_IN = 16 * 176, I_OUT = 44 * 32, I_ABI = 16 * 72, I_O = 16 * 32, I_FXI = 16 * 96;
            constexpr int NITEMS = 4 * I_IN + 4 * I_OUT + I_ABI + I_O + I_FXI + I_O;
            for (int it = gw; it < NITEMS; it += NGW) {
                int r = it; const float* src; int ldw, K, nblk; bf16_t* dst; int mode = 0;
                if (r < 4 * I_IN) { const int idx = r / I_IN; r -= idx * I_IN; src = ap->in[(idx & 1) ? 5 : 3] + (size_t)(idx >> 1) * D_MODEL * 2 * D_FF; ldw = 2 * D_FF; K = D_MODEL; nblk = 176; dst = (bf16_t*)(ws + WS_FFN_IN + idx * FFN_IN_BYTES); mode = 1; }
                else if ((r -= 4 * I_IN) < 4 * I_OUT) { const int idx = r / I_OUT; r -= idx * I_OUT; src = ap->in[(idx & 1) ? 6 : 4] + (size_t)(idx >> 1) * D_FF * D_MODEL; ldw = D_MODEL; K = D_FF; nblk = 32; dst = (bf16_t*)(ws + WS_FFN_OUT + idx * FFN_OUT_BYTES); }
                else if ((r -= 4 * I_OUT) < I_ABI) { src = ap->in[7]; ldw = AB_IN; K = D_MODEL; nblk = 72; dst = (bf16_t*)(ws + WS_AB_IN); }
                else if ((r -= I_ABI) < I_O) { src = ap->in[8]; ldw = D_MODEL; K = D_MODEL; nblk = 32; dst = (bf16_t*)(ws + WS_AB_OUT); }
                else if ((r -= I_O) < I_FXI) { src = ap->in[10]; ldw = FOX_IN; K = D_MODEL; nblk = 96; dst = (bf16_t*)(ws + WS_FOX_IN); }
                else { r -= I_FXI; src = ap->in[12]; ldw = D_MODEL; K = D_MODEL; nblk = 32; dst = (bf16_t*)(ws + WS_FOX_OUT); }
                const int kb = r / nblk, nb = r - kb * nblk, n0 = 32 * nb;
                int drow0 = n0;
                if (mode == 1) { const int j = n0 < D_FF ? n0 : n0 - D_FF; drow0 = 256 * (j >> 7) + (j & 127) + (n0 < D_FF ? 0 : 128); }
                transpose_item(src, ldw, K, dst, 64 * kb, n0, drow0, scr, lane);
            }
            if (bid == 0) { unsigned* ctl = (unsigned*)(ws + WS_CTL); for (int i = tid; i < XCD_BAR_WORDS; i += 512) ctl[i] = 0u; }
            { unsigned* ctl = (unsigned*)(ws + WS_CTL) + CNT_OFF; for (int i = bid * 512 + tid; i < CNT_WORDS; i += G * 512) ctl[i] = 0u; }
            { bf16_t* dst = (bf16_t*)(ws + WS_FOX_IN); const float* src = ap->in[10];
              for (int i = bid * 512 + tid; i < 16 * D_MODEL; i += G * 512) { const int n = i >> 10, k = i & 1023; dst[(size_t)(FOX_QKV + n) * D_MODEL + k] = (bf16_t)f2bf(src[(size_t)k * FOX_IN + FOX_QKV + n]); } }
            for (int mrow = gw; mrow < MTOK; mrow += NGW) {
                const float* xr = ap->in[0] + (size_t)mrow * D_MODEL; bf16_t* hr = HB + (size_t)mrow * D_MODEL; unsigned char* lr = ws + WS_LO + (size_t)mrow * D_MODEL;
#pragma unroll
                for (int j = 0; j < 2; ++j) { const int c8 = 8 * (lane + 64 * j); u32x4 wv; u32x2 qv;
#pragma unroll
                    for (int n = 0; n < 2; ++n) { const f32x4 v = *(const f32x4*)(xr + c8 + 4 * n); const unsigned w0 = cvt_pk(v[0], v[1]), w1 = cvt_pk(v[2], v[3]);
                        const float l0 = (v[0] - __builtin_bit_cast(float, w0 << 16)) * 4096.f + 128.5f, l1 = (v[1] - __builtin_bit_cast(float, w0 & 0xffff0000u)) * 4096.f + 128.5f;
                        const float l2 = (v[2] - __builtin_bit_cast(float, w1 << 16)) * 4096.f + 128.5f, l3 = (v[3] - __builtin_bit_cast(float, w1 & 0xffff0000u)) * 4096.f + 128.5f;
                        const unsigned q = (unsigned)(int)fminf(fmaxf(l0, 0.f), 255.f) | ((unsigned)(int)fminf(fmaxf(l1, 0.f), 255.f) << 8) | ((unsigned)(int)fminf(fmaxf(l2, 0.f), 255.f) << 16) | ((unsigned)(int)fminf(fmaxf(l3, 0.f), 255.f) << 24);
                        if (n == 0) { wv.x = w0; wv.y = w1; qv.x = q; } else { wv.z = w0; wv.w = w1; qv.y = q; } }
                    *(u32x4*)(hr + c8) = wv; *(u32x2*)(lr + (c8 & ~255) + 64 * ((c8 >> 5) & 3) + 16 * ((c8 >> 3) & 3) + 8 * ((c8 >> 7) & 1)) = qv; }
            }
        } else {
            const int L = (p - 1) / 7, s = (p - 1) % 7;
            if (EN_G1 && (s == 0 || s == 5)) {
                const int idx = L * 2 + (s == 5 ? 1 : 0);
                pg8::Gemm g{HB, (const bf16_t*)(ws + WS_FFN_IN + idx * FFN_IN_BYTES), MTOK, 2 * D_FF, D_MODEL};
                pg8::StaticOrder S; S.init(MTOK, 2 * D_FF, G, bid, WGM_FFN_IN);
                pg8::EpiSwiGLU E{BIG, D_FF};
                pg8::gemm_phase<pg8::EpiSwiGLU, pg8::StaticOrder>(lds, g, S, E);
            } else if (EN_G2 && (s == 1 || s == 4 || s == 6)) {
                const bf16_t* A; const bf16_t* Bt; int K; float cs;
                const int li = L * 3 + (s == 1 ? 0 : (s == 4 ? 1 : 2));
                if (s == 4) { A = OB; Bt = (const bf16_t*)(ws + (L == 0 ? WS_AB_OUT : WS_FOX_OUT)); K = D_MODEL; cs = 1.f; }
                else { const int idx = L * 2 + (s == 6 ? 1 : 0); A = BIG; Bt = (const bf16_t*)(ws + WS_FFN_OUT + idx * FFN_OUT_BYTES); K = D_FF; cs = 0.5f; }
                pg8::Gemm g{A, Bt, MTOK, D_MODEL, K};
                pg8::StaticOrder S; S.init(MTOK, D_MODEL, G, bid, WGM_OUT);
                pg8::EpiLnFused E{(L == 1 && s == 6) ? out : (float*)nullptr, HB, ws + WS_LO, ALPHA, cs, ap->in[1] + (size_t)li * D_MODEL, ap->in[2] + (size_t)li * D_MODEL,
                                  (unsigned long long*)(ws + WS_XBUF), (unsigned*)(ws + WS_CTL) + CNT_OFF + li * 128 * 64, lds + LDS_X_OFF};
                pg8::gemm_phase<pg8::EpiLnFused, pg8::StaticOrder>(lds, g, S, E);
            } else if (EN_G3 && s == 2) {
                const bool ab = (L == 0);
                if (!ab) {
                    const bf16_t* wf = (const bf16_t*)(ws + WS_FOX_IN) + (size_t)FOX_QKV * D_MODEL;
                    for (int task = gw; task < MTOK / 16; task += NGW) {
                        const bf16_t* ap_ = HB + (size_t)(task * 16 + (lane & 15)) * D_MODEL + 8 * (lane >> 4); const bf16_t* bp_ = wf + (size_t)(lane & 15) * D_MODEL + 8 * (lane >> 4);
                        f32x4 fa = (f32x4){0.f, 0.f, 0.f, 0.f};
#pragma unroll 8
                        for (int k = 0; k < D_MODEL; k += 32) fa = __builtin_amdgcn_mfma_f32_16x16x32_bf16(*(const bf16x8*)(ap_ + k), *(const bf16x8*)(bp_ + k), fa, 0, 0, 0);
                        *(f32x4*)(FB + (size_t)(lane & 15) * MTOK + task * 16 + 4 * (lane >> 4)) = fa;
                    }
                }
                pg8::Gemm g{HB, (const bf16_t*)(ws + (ab ? WS_AB_IN : WS_FOX_IN)), MTOK, ab ? AB_IN : FOX_QKV, D_MODEL};
                pg8::StaticOrder S; S.init(MTOK, g.N, G, bid, WGM_QKV);
                pg8::EpiQKV E{BIG, ab ? AB_IN : FOX_QKV, ab ? 0xC3u : 0xFu, FB, -1};
                pg8::gemm_phase<pg8::EpiQKV, pg8::StaticOrder>(lds, g, S, E);
            } else if (s == 3) {
                if (L == 0) {
                    for (int job = bid; job < 256; job += G) {
                        if (EN_SB) { const int bh = job >> 1, which = job & 1, b = bh >> 3, h = bh & 7;
                          for (int i = 0; i < 4; ++i) { const int qb = which ? (i == 0 ? 6 : i == 1 ? 5 : i == 2 ? 2 : 1) : (i == 0 ? 7 : i == 1 ? 4 : i == 2 ? 3 : 0);
                              att::attn_unit<att::M_SB>(lds, BIG, AB_IN, h * 64, 512 + h * 64, 1024 + h * 64, OB, h * 64, b, qb, 0.f, 0.f); } }
                        if (EN_SWA) for (int i = 0; i < 4; ++i) { const int idx = job * 4 + i, qb = idx & 7, hq = (idx >> 3) & 7, b = idx >> 6;
                            LAS float* lut = (LAS float*)(lds + att::OFF_LUT_SWA);
                            if (tid < att::LUT_N) { const int rel = tid - 64; lut[tid] = (rel >= 0 && rel < 128) ? ap->in[13][att::t5_bucket(rel) * 8 + hq] * LOG2E : 0.f; }
                            const float sinkv = ap->in[9][hq] * LOG2E;
                            att::attn_unit<att::M_SWA>(lds, BIG, AB_IN, 1536 + hq * 64, 2048 + (hq >> 2) * 64, 2176 + (hq >> 2) * 64, OB, 512 + hq * 64, b, qb, sinkv, 0.f); }
                    }
                } else {
                    if (EN_FOX) for (int job = bid; job < 256; job += G) {
                        const int b = job >> 4, h = job & 15;
                        LAS float* carr = (LAS float*)(lds + att::OFF_C); LAS float* wsum = (LAS float*)(lds + att::OFF_LUT);
                        const float bfh = ap->in[11][h];
                        float v[4]; const f32x4 fv = *(const f32x4*)(FB + (size_t)h * MTOK + (size_t)b * SEQ + tid * 4);
#pragma unroll
                        for (int i = 0; i < 4; ++i) { const float f = fv[i] + bfh; v[i] = (fminf(f, 0.f) - log1pf(expf(-fabsf(f)))) * LOG2E; }
                        v[1] += v[0]; v[2] += v[1]; v[3] += v[2];
                        float x = v[3];
#pragma unroll
                        for (int o = 1; o < 64; o <<= 1) { const float y = __shfl_up(x, o); if (lane >= o) x += y; }
                        float excl = __shfl_up(x, 1); if (lane == 0) excl = 0.f;
                        float kn = 0.f;
                        for (int i = 0; i < 4; ++i) { const u32x4* kp = (const u32x4*)(BIG + ((size_t)b * SEQ + tid * 4 + i) * FOX_QKV + 1024 + h * 64); float ss = 0.f;
#pragma unroll
                            for (int c = 0; c < 8; ++c) { const u32x4 kv = kp[c];
#pragma unroll
                                for (int e = 0; e < 4; ++e) { const float lo = __builtin_bit_cast(float, kv[e] << 16), hi2 = __builtin_bit_cast(float, kv[e] & 0xffff0000u); ss += lo * lo + hi2 * hi2; } }
                            kn = fmaxf(kn, ss); }
#pragma unroll
                        for (int o = 1; o < 64; o <<= 1) kn = fmaxf(kn, __shfl_xor(kn, o));
                        if (lane == 63) { wsum[wave] = x; wsum[8 + wave] = kn; }
                        __syncthreads();
                        float woff = 0.f, kmax = 0.f;
                        for (int i = 0; i < wave; ++i) woff += wsum[i];
                        for (int i = 0; i < 8; ++i) kmax = fmaxf(kmax, wsum[8 + i]);
                        kmax = sqrtf(kmax);
#pragma unroll
                        for (int i = 0; i < 4; ++i) carr[tid * 4 + i] = -(v[i] + excl + woff);
                        __syncthreads();
                        for (int qb = 7; qb >= 0; --qb)
                            att::attn_unit<att::M_FOX>(lds, BIG, FOX_QKV, h * 64, 1024 + h * 64, 2048 + h * 64, OB, h * 64, b, qb, 0.f, kmax);
                        __syncthreads();
                    }
                }
            }
        }
        if (pp + 1 < args.ph_hi) {
            if (pp == 0) { grid.sync();
                if (threadIdx.x == 0) (void)xb_add((unsigned*)(ap->ws + WS_CTL) + XB_XCNT(xb_xcc_id()), 1u); }
            else xcd_barrier((unsigned*)(ap->ws + WS_CTL), (volatile LAS unsigned*)(lds + LDS_ST_OFF));
        }
    }
}

extern "C" void kernel_launch(void* const* d_in, const int* in_sizes, int n_in, void* d_out, int out_size, void* d_ws, size_t ws_size, hipStream_t stream) {
    static int grid = 0;
    if (grid == 0) {
        if (n_in != 14 || out_size != MTOK * D_MODEL || ws_size < WS_END) { fprintf(stderr, "kernel_launch: unexpected problem (n_in %d, out %d, ws %zu)\n", n_in, out_size, ws_size); grid = -1; return; }
        int dev = 0, cus = 0, per_cu = 0;
        hipGetDevice(&dev); hipDeviceGetAttribute(&cus, hipDeviceAttributeMultiprocessorCount, dev);
        if (hipFuncSetAttribute((const void*)mega, hipFuncAttributeMaxDynamicSharedMemorySize, LDS_BYTES) != hipSuccess) { fprintf(stderr, "kernel_launch: hipFuncSetAttribute failed\n"); grid = -1; return; }
        if (hipOccupancyMaxActiveBlocksPerMultiprocessor(&per_cu, (const void*)mega, 512, LDS_BYTES) != hipSuccess || per_cu < 1) per_cu = 1;
        (void)hipGetLastError();
        grid = cus * per_cu;
        if (grid > 256) grid = 256;
        if (grid != 256) { fprintf(stderr, "kernel_launch: the fused LayerNorm epilogues need exactly 256 resident workgroups (got %d); nothing launched\n", grid); grid = -1; return; }
    }
    if (grid < 0) return;
    Args a{};
    for (int i = 0; i < 14; ++i) a.in[i] = (const float*)d_in[i];
    a.out = (float*)d_out; a.ws = (unsigned char*)d_ws;
#if MK_N_LAUNCHES == 1
    a.ph_lo = 0; a.ph_hi = N_PHASES;
    void* kargs[] = {&a};
    hipError_t e = hipLaunchCooperativeKernel((const void*)mega, dim3(grid), dim3(512), kargs, LDS_BYTES, stream);
    if (e != hipSuccess) fprintf(stderr, "cooperative launch failed: %s (grid %d)\n", hipGetErrorString(e), grid);
#else
    for (int p = 0; p < N_PHASES; ++p) { a.ph_lo = p; a.ph_hi = p + 1; hipLaunchKernelGGL(mega, dim3(grid), dim3(512), LDS_BYTES, stream, a); }
#endif
}
```
